# Optimizing an MI355X kernel written in HIP

```python
import math
import jax, jax.numpy as jnp
from jax import lax
import numpy as np

D_MODEL = 1024
BATCH = 8
SEQ = 2048
DEPTH = 1

GRID_W = 64
CTX_LEN = 256
EPS = 1e-6

SSM_WIDTH = D_MODEL // 2
SSM_GROUP = 16
SSM_GROUPS = SSM_WIDTH // SSM_GROUP
SSM_STATE = 64
DT_MIN = 1e-3
DT_MAX = 1e-1

CONV_WIDTH = D_MODEL // 2
CONV_K = 3

OFF_U = 0
OFF_CB = OFF_U + SSM_WIDTH
OFF_CC = OFF_CB + CONV_WIDTH
OFF_CV = OFF_CC + CONV_WIDTH
OFF_GA = OFF_CV + CONV_WIDTH
OFF_GB = OFF_GA + D_MODEL
IN_COLS = OFF_GB + D_MODEL

N_EXPERTS = 256
TOP_K = 8
N_EXPERT_GROUPS = 8
EXPERTS_PER_GROUP = N_EXPERTS // N_EXPERT_GROUPS
TOP_K_GROUPS = 4
EXPERT_DIM = D_MODEL // 4
SHARED_DIM = EXPERT_DIM
ROUTE_SCALE = 2.5
MOE_BLOCK = 128

kernel_name = 'hybrid_s5_shortconv_moe_dit_block'


def _rmsnorm(x, g):
    xf = x.astype(jnp.float32)
    y = xf * lax.rsqrt(jnp.mean(xf * xf, axis=-1, keepdims=True) + EPS)
    return (y * g.astype(jnp.float32)).astype(x.dtype)


def _swiglu(t, wg, wu, wd):
    return (jax.nn.silu(t @ wg) * (t @ wu)) @ wd


def _zoh(lam_re, lam_im, log_dt, b_re, b_im):
    f32 = jnp.float32
    lam_re, lam_im, log_dt, b_re, b_im = (a.astype(f32) for a in (lam_re, lam_im, log_dt, b_re, b_im))
    dt = jnp.exp(log_dt)[:, None]
    mag = jnp.exp(lam_re * dt)
    a_re = mag * jnp.cos(lam_im * dt)
    a_im = mag * jnp.sin(lam_im * dt)
    den = lam_re * lam_re + lam_im * lam_im
    k_re = ((a_re - 1.0) * lam_re + a_im * lam_im) / den
    k_im = (a_im * lam_re - (a_re - 1.0) * lam_im) / den
    bb_re = k_re[..., None] * b_re - k_im[..., None] * b_im
    bb_im = k_re[..., None] * b_im + k_im[..., None] * b_re
    return a_re, a_im, bb_re, bb_im


def _drive(u, bb_re, bb_im):
    ug = u.reshape(u.shape[0], u.shape[1], SSM_GROUPS, SSM_GROUP)
    return (jnp.einsum('blgc,gpc->blgp', ug, bb_re), jnp.einsum('blgc,gpc->blgp', ug, bb_im))


def _readout(s_re, s_im, c_re, c_im):
    y = jnp.einsum('blgp,gcp->blgc', s_re, c_re) - jnp.einsum('blgp,gcp->blgc', s_im, c_im)
    return y.reshape(y.shape[0], y.shape[1], SSM_WIDTH)


def _scan_combine(e1, e2):
    a1r, a1i, b1r, b1i = e1
    a2r, a2i, b2r, b2i = e2
    return (a2r * a1r - a2i * a1i, a2r * a1i + a2i * a1r,
            a2r * b1r - a2i * b1i + b2r, a2r * b1i + a2i * b1r + b2i)


def _complex_scan(a_re, a_im, bu_re, bu_im, s0=None):
    if s0 is not None:
        s0_re, s0_im = s0
        bu_re = bu_re.at[:, 0].add(a_re * s0_re - a_im * s0_im)
        bu_im = bu_im.at[:, 0].add(a_re * s0_im + a_im * s0_re)
    length = bu_re.shape[1]
    ar = jnp.broadcast_to(a_re, (1, length) + a_re.shape)
    ai = jnp.broadcast_to(a_im, (1, length) + a_im.shape)
    _, _, s_re, s_im = lax.associative_scan(_scan_combine, (ar, ai, bu_re, bu_im), axis=1)
    return s_re, s_im


def _s5_direction(ul, uc, lam_re, lam_im, log_dt, b_re, b_im, c_re, c_im, reverse, with_ctx):
    a_re, a_im, bb_re, bb_im = _zoh(lam_re, lam_im, log_dt, b_re, b_im)
    c_re = c_re.astype(jnp.float32)
    c_im = c_im.astype(jnp.float32)
    if reverse:
        ul = jnp.flip(ul, axis=1)
        uc = jnp.flip(uc, axis=1)
    sc_re, sc_im = _complex_scan(a_re, a_im, *_drive(uc, bb_re, bb_im))
    sl_re, sl_im = _complex_scan(a_re, a_im, *_drive(ul, bb_re, bb_im), s0=(sc_re[:, -1], sc_im[:, -1]))
    y_lat = _readout(sl_re, sl_im, c_re, c_im)
    y_ctx = _readout(sc_re, sc_im, c_re, c_im) if with_ctx else None
    if reverse:
        y_lat = jnp.flip(y_lat, axis=1)
        y_ctx = jnp.flip(y_ctx, axis=1) if with_ctx else None
    return y_lat, y_ctx


def _glu(y, w_glu):
    a, b = jnp.split(jax.nn.gelu(y) @ w_glu, 2, axis=-1)
    return a * jax.nn.sigmoid(b)


def _s5_branch(u_lat, u_ctx, lam_re, lam_im, log_dt, b_re, b_im, c_re, c_im, d, w_glu, with_ctx):
    dtype = u_lat.dtype
    ul = u_lat.astype(jnp.float32)
    uc = u_ctx.astype(jnp.float32)
    dd = d.astype(jnp.float32)
    y_lat = dd * ul
    y_ctx = dd * uc
    for direction in range(2):
        yl, yc = _s5_direction(ul, uc, lam_re[direction], lam_im[direction], log_dt[direction],
                               b_re[direction], b_im[direction], c_re[direction], c_im[direction],
                               direction == 1, with_ctx)
        y_lat = y_lat + yl
        if with_ctx:
            y_ctx = y_ctx + yc
    out_lat = _glu(y_lat.astype(dtype), w_glu)
    out_ctx = _glu(y_ctx.astype(dtype), w_glu) if with_ctx else None
    return out_lat, out_ctx


def _dwconv(z, w):
    k = w.reshape(CONV_K, 1, -1).astype(z.dtype)
    return lax.conv_general_dilated(z, k, window_strides=(1,), padding=[(CONV_K // 2, CONV_K // 2)],
                                    dimension_numbers=('NWC', 'WIO', 'NWC'),
                                    feature_group_count=z.shape[-1])


def _grid_conv(z, w):
    b, length, ch = z.shape
    rows = length // GRID_W
    return _dwconv(z.reshape(b * rows, GRID_W, ch), w).reshape(b, length, ch)


def _mixer_out(proj, y_ssm, conv_fn, w_ssm_out, conv_w, w_conv_out, w_o):
    cb = proj[..., OFF_CB:OFF_CC]
    cc = proj[..., OFF_CC:OFF_CV]
    cv = proj[..., OFF_CV:OFF_GA]
    ga = proj[..., OFF_GA:OFF_GB]
    gb = proj[..., OFF_GB:IN_COLS]
    y_conv = (cb * conv_fn(cc * cv, conv_w)) @ w_conv_out
    y_a = y_ssm @ w_ssm_out
    merged = jax.nn.sigmoid(ga) * y_a + jax.nn.sigmoid(gb) * y_conv
    return merged @ w_o


def _routed_experts(t, eidx, wts, w_gate, w_up, w_down):
    n = t.shape[0]
    nk = n * TOP_K
    e_flat = eidx.reshape(-1)
    tok_flat = jnp.repeat(jnp.arange(n, dtype=jnp.int32), TOP_K)
    w_flat = wts.reshape(-1)
    order = jnp.argsort(e_flat)
    e_s, tok_s, w_s = e_flat[order], tok_flat[order], w_flat[order]
    counts = jnp.bincount(e_flat, length=N_EXPERTS)
    starts = jnp.cumsum(counts) - counts
    padded = (counts + MOE_BLOCK - 1) // MOE_BLOCK * MOE_BLOCK
    pends = jnp.cumsum(padded)
    pstarts = pends - padded
    dest = pstarts[e_s] + jnp.arange(nk, dtype=jnp.int32) - starts[e_s]
    n_blocks = -(-nk // MOE_BLOCK) + N_EXPERTS
    cap = n_blocks * MOE_BLOCK
    slot_tok = jnp.zeros((cap,), jnp.int32).at[dest].set(tok_s)
    slot_w = jnp.zeros((cap,), t.dtype).at[dest].set(w_s)
    block_expert = jnp.clip(jnp.searchsorted(pends, jnp.arange(n_blocks, dtype=jnp.int32) * MOE_BLOCK,
                                             side='right'), 0, N_EXPERTS - 1)

    def block(args):
        e, toks, ws = args
        return _swiglu(t[toks], w_gate[e], w_up[e], w_down[e]) * ws[:, None]

    y = lax.map(block, (block_expert, slot_tok.reshape(n_blocks, MOE_BLOCK), slot_w.reshape(n_blocks, MOE_BLOCK)))
    return jax.ops.segment_sum(y.reshape(cap, D_MODEL), slot_tok, num_segments=n)


def _moe(h, w_router, router_bias, w_gate, w_up, w_down, ws_gate, ws_up, ws_down):
    shape = h.shape
    t = h.reshape(-1, D_MODEL)
    n = t.shape[0]
    scores = jax.nn.sigmoid((t @ w_router).astype(jnp.float32))
    choice = scores + router_bias.astype(jnp.float32)
    grp_score = jnp.sum(lax.top_k(choice.reshape(n, N_EXPERT_GROUPS, EXPERTS_PER_GROUP), 2)[0], axis=-1)
    _, gidx = lax.top_k(grp_score, TOP_K_GROUPS)
    gmask = jnp.zeros((n, N_EXPERT_GROUPS), bool).at[jnp.arange(n)[:, None], gidx].set(True)
    choice = jnp.where(jnp.repeat(gmask, EXPERTS_PER_GROUP, axis=1), choice, -jnp.inf)
    _, eidx = lax.top_k(choice, TOP_K)
    wts = jnp.take_along_axis(scores, eidx, axis=1)
    wts = wts / jnp.sum(wts, axis=-1, keepdims=True) * ROUTE_SCALE
    routed = _routed_experts(t, eidx, wts.astype(t.dtype), w_gate, w_up, w_down)
    shared = _swiglu(t, ws_gate, ws_up, ws_down)
    return (routed + shared).reshape(shape)


def setup_inputs(seed: int = 0) -> dict:
    key = jax.random.key(seed)
    ks = iter(jax.random.split(key, 31))

    def nrm(shape, scale):
        return scale * jax.random.normal(next(ks), shape, jnp.float32)

    G, P, Q = SSM_GROUPS, SSM_STATE, SSM_GROUP
    x = nrm((BATCH, SEQ, D_MODEL), 1.0)
    c = nrm((BATCH, D_MODEL), 1.0)
    ctx = nrm((BATCH, CTX_LEN, D_MODEL), 1.0)
    c_ctx = nrm((D_MODEL,), 1.0)
    w_mod = nrm((DEPTH, D_MODEL, 6 * D_MODEL), 0.5 * D_MODEL ** -0.5)
    b_mod = nrm((DEPTH, 6 * D_MODEL), 0.02)
    norm1_g = 1.0 + nrm((DEPTH, D_MODEL), 0.02)
    norm2_g = 1.0 + nrm((DEPTH, D_MODEL), 0.02)
    w_in = nrm((DEPTH, D_MODEL, IN_COLS), D_MODEL ** -0.5)
    ssm_lam_re = -0.5 + nrm((DEPTH, 2, G, P), 0.01)
    ssm_lam_im = jnp.pi * jnp.arange(P, dtype=jnp.float32) + nrm((DEPTH, 2, G, P), 0.01)
    ssm_log_dt = jax.random.uniform(next(ks), (DEPTH, 2, G), jnp.float32, math.log(DT_MIN), math.log(DT_MAX))
    ssm_b_re = nrm((DEPTH, 2, G, P, Q), (2 * Q) ** -0.5)
    ssm_b_im = nrm((DEPTH, 2, G, P, Q), (2 * Q) ** -0.5)
    ssm_c_re = nrm((DEPTH, 2, G, Q, P), (2 * P) ** -0.5)
    ssm_c_im = nrm((DEPTH, 2, G, Q, P), (2 * P) ** -0.5)
    ssm_d = nrm((DEPTH, SSM_WIDTH), 1.0)
    w_glu = nrm((DEPTH, SSM_WIDTH, 2 * SSM_WIDTH), SSM_WIDTH ** -0.5)
    w_ssm_out = nrm((DEPTH, SSM_WIDTH, D_MODEL), SSM_WIDTH ** -0.5)
    conv_w = nrm((DEPTH, CONV_K, CONV_WIDTH), CONV_K ** -0.5)
    w_conv_out = nrm((DEPTH, CONV_WIDTH, D_MODEL), CONV_WIDTH ** -0.5)
    w_o = nrm((DEPTH, D_MODEL, D_MODEL), D_MODEL ** -0.5)
    w_router = nrm((DEPTH, D_MODEL, N_EXPERTS), D_MODEL ** -0.5)
    router_bias = nrm((DEPTH, N_EXPERTS), 0.01)
    w_gate = nrm((DEPTH, N_EXPERTS, D_MODEL, EXPERT_DIM), D_MODEL ** -0.5)
    w_up = nrm((DEPTH, N_EXPERTS, D_MODEL, EXPERT_DIM), D_MODEL ** -0.5)
    w_down = nrm((DEPTH, N_EXPERTS, EXPERT_DIM, D_MODEL), EXPERT_DIM ** -0.5)
    ws_gate = nrm((DEPTH, D_MODEL, SHARED_DIM), D_MODEL ** -0.5)
    ws_up = nrm((DEPTH, D_MODEL, SHARED_DIM), D_MODEL ** -0.5)
    ws_down = nrm((DEPTH, SHARED_DIM, D_MODEL), SHARED_DIM ** -0.5)
    final_g = 1.0 + nrm((D_MODEL,), 0.02)
    return {'x': x, 'c': c, 'ctx': ctx, 'c_ctx': c_ctx, 'w_mod': w_mod, 'b_mod': b_mod,
            'norm1_g': norm1_g, 'norm2_g': norm2_g, 'w_in': w_in,
            'ssm_lam_re': ssm_lam_re, 'ssm_lam_im': ssm_lam_im, 'ssm_log_dt': ssm_log_dt,
            'ssm_b_re': ssm_b_re, 'ssm_b_im': ssm_b_im, 'ssm_c_re': ssm_c_re, 'ssm_c_im': ssm_c_im,
            'ssm_d': ssm_d, 'w_glu': w_glu, 'w_ssm_out': w_ssm_out, 'conv_w': conv_w,
            'w_conv_out': w_conv_out, 'w_o': w_o, 'w_router': w_router, 'router_bias': router_bias,
            'w_gate': w_gate, 'w_up': w_up, 'w_down': w_down, 'ws_gate': ws_gate, 'ws_up': ws_up,
            'ws_down': ws_down, 'final_g': final_g}


def reference(x, c, ctx, c_ctx, w_mod, b_mod, norm1_g, norm2_g, w_in, ssm_lam_re, ssm_lam_im, ssm_log_dt,
              ssm_b_re, ssm_b_im, ssm_c_re, ssm_c_im, ssm_d, w_glu, w_ssm_out, conv_w, w_conv_out, w_o,
              w_router, router_bias, w_gate, w_up, w_down, ws_gate, ws_up, ws_down, final_g):
    xl = x
    xc = ctx
    for layer in range(DEPTH):
        last = layer == DEPTH - 1
        mod = jax.nn.silu(c) @ w_mod[layer] + b_mod[layer]
        mod_c = jax.nn.silu(c_ctx) @ w_mod[layer] + b_mod[layer]
        sh1, sc1, g1, sh2, sc2, g2 = (m[:, None, :] for m in jnp.split(mod, 6, axis=-1))
        csh1, csc1, cg1, csh2, csc2, cg2 = jnp.split(mod_c, 6, axis=-1)

        h = _rmsnorm(xl, norm1_g[layer]) * (1 + sc1) + sh1
        hc = _rmsnorm(xc, norm1_g[layer]) * (1 + csc1) + csh1
        proj = h @ w_in[layer]
        proj_c = hc @ (w_in[layer][:, :SSM_WIDTH] if last else w_in[layer])

        y_ssm, y_ssm_c = _s5_branch(proj[..., OFF_U:OFF_CB], proj_c[..., OFF_U:OFF_CB],
                                    ssm_lam_re[layer], ssm_lam_im[layer], ssm_log_dt[layer],
                                    ssm_b_re[layer], ssm_b_im[layer], ssm_c_re[layer], ssm_c_im[layer],
                                    ssm_d[layer], w_glu[layer], not last)

        xl = xl + g1 * _mixer_out(proj, y_ssm, _grid_conv, w_ssm_out[layer], conv_w[layer],
                                  w_conv_out[layer], w_o[layer])
        h2 = _rmsnorm(xl, norm2_g[layer]) * (1 + sc2) + sh2
        xl = xl + g2 * _moe(h2, w_router[layer], router_bias[layer], w_gate[layer], w_up[layer], w_down[layer],
                            ws_gate[layer], ws_up[layer], ws_down[layer])

        if not last:
            xc = xc + cg1 * _mixer_out(proj_c, y_ssm_c, _dwconv, w_ssm_out[layer], conv_w[layer],
                                       w_conv_out[layer], w_o[layer])
            hc2 = _rmsnorm(xc, norm2_g[layer]) * (1 + csc2) + csh2
            xc = xc + cg2 * _moe(hc2, w_router[layer], router_bias[layer], w_gate[layer], w_up[layer],
                                 w_down[layer], ws_gate[layer], ws_up[layer], ws_down[layer])
    return _rmsnorm(xl, final_g)
```

```cpp
#include <hip/hip_runtime.h>
#include <cstdio>
#include <cstdint>

typedef unsigned short bf16;
typedef short bf16x8 __attribute__((ext_vector_type(8)));
typedef float f32x4 __attribute__((ext_vector_type(4)));
typedef unsigned u32x4 __attribute__((ext_vector_type(4)));
typedef unsigned u32x2 __attribute__((ext_vector_type(2)));

constexpr int D = 1024, NB = 8, SEQ = 2048, CTXL = 256;
constexpr int NTOK = NB * SEQ, NCTX = NB * CTXL, NROW = NTOK + NCTX;
constexpr int INC = 4096, SG = 32, SP = 64, SQ = 16, CT = 16;
constexpr int NCH = SEQ / CT, NCHC = CTXL / CT, NCHT = NCH + NCHC;
constexpr int NE = 256, TOPK = 8, ED = 256;
constexpr float EPS = 1e-6f;
constexpr int KSPLIT = 16;
constexpr int LIST_CAP = NTOK;
constexpr int HB_ROWS = NTOK * TOPK + NE * 256;

constexpr size_t MiB = 1u << 20;
constexpr size_t WS_CTL = 0;
constexpr size_t WS_MODP = 1 * MiB;
constexpr size_t WS_MOD = 5 * MiB;
constexpr size_t WS_A16 = 5 * MiB + 512 * 1024;
constexpr size_t WS_START = 5 * MiB + 768 * 1024;
constexpr size_t WS_WIN_T = 6 * MiB;
constexpr size_t WS_WGLU_T = 14 * MiB;
constexpr size_t WS_WSSM_T = 15 * MiB;
constexpr size_t WS_WCONV_T = 16 * MiB;
constexpr size_t WS_WO_T = 17 * MiB;
constexpr size_t WS_WRS_T = 19 * MiB;
constexpr size_t WS_WSD_T = 21 * MiB;
constexpr size_t WS_MG = 22 * MiB;
constexpr size_t WS_WINS = 30 * MiB;
constexpr size_t WS_WGU_T = 34 * MiB;
constexpr size_t WS_WD_T = 290 * MiB;
constexpr size_t WS_H1 = 418 * MiB;
constexpr size_t WS_AG = 454 * MiB;
constexpr size_t WS_UC = 486 * MiB;
constexpr size_t WS_SLOC = 488 * MiB;
constexpr size_t WS_CBV = 524 * MiB;
constexpr size_t WS_GATES = 572 * MiB;
constexpr size_t WS_CBR = 636 * MiB;
constexpr size_t WS_YG = 652 * MiB;
constexpr size_t WS_GLU = 668 * MiB;
constexpr size_t WS_MERGED = 684 * MiB;
constexpr size_t WS_YSLOT = 418 * MiB;
constexpr size_t WS_XL1 = 716 * MiB;
constexpr size_t WS_H2 = 780 * MiB;
constexpr size_t WS_SCORES = 812 * MiB;
constexpr size_t WS_HS = 828 * MiB;
constexpr size_t WS_TW = 836 * MiB;
constexpr size_t WS_LIST = 838 * MiB;
constexpr size_t WS_HBUF = 854 * MiB;
constexpr size_t WS_END = 950 * MiB;
constexpr int CW_CNT = 0;

__device__ __forceinline__ unsigned f2bf(float f) { unsigned u = __builtin_bit_cast(unsigned, f); return (u + 0x7fffu + ((u >> 16) & 1u)) >> 16; }
__device__ __forceinline__ unsigned pk2(float lo, float hi) { return f2bf(lo) | (f2bf(hi) << 16); }
__device__ __forceinline__ float bf2f(unsigned h) { return __builtin_bit_cast(float, (h & 0xffffu) << 16); }
__device__ __forceinline__ float sigmoidf_(float v) { return 1.0f / (1.0f + __expf(-v)); }
__device__ __forceinline__ float siluf_(float v) { return v / (1.0f + __expf(-v)); }
__device__ __forceinline__ float gelu_tanh(float v) { const float u = 0.7978845608028654f * (v + 0.044715f * v * v * v); return 0.5f * v * (1.0f + tanhf(u)); }
__device__ __forceinline__ float wave_sum(float v) {
#pragma unroll
    for (int o = 1; o < 64; o <<= 1) v += __shfl_xor(v, o);
    return v;
}

struct Ptrs {
    const float* in[31];
    float* out;
    unsigned char* ws;
};

__device__ __forceinline__ void mod_partial_item(const Ptrs& P, int item, int t, float* sil  ) {
    const int jb = item % 24, ks = item / 24;
    const float* c = P.in[1]; const float* cc = P.in[3]; const float* wm = P.in[4];
    __syncthreads();
    for (int i = t; i < 9 * 64; i += blockDim.x) { const int r = i / 64, k = ks * 64 + (i % 64); const float v = r < 8 ? c[r * D + k] : cc[k]; sil[i] = siluf_(v); }
    __syncthreads();
    if (t < 256) {
        const int j = jb * 256 + t;
        float acc[9];
#pragma unroll
        for (int r = 0; r < 9; ++r) acc[r] = 0.f;
        for (int kk = 0; kk < 64; ++kk) { const float w = wm[(size_t)(ks * 64 + kk) * 6144 + j];
#pragma unroll
            for (int r = 0; r < 9; ++r) acc[r] += sil[r * 64 + kk] * w; }
        float* mp = (float*)(P.ws + WS_MODP);
#pragma unroll
        for (int r = 0; r < 9; ++r) mp[((size_t)ks * 9 + r) * 6144 + j] = acc[r];
    }
}
__device__ __forceinline__ void mod_reduce(const Ptrs& P, int gtid, int gthreads) {
    const float* mp = (const float*)(P.ws + WS_MODP); float* mod = (float*)(P.ws + WS_MOD); const float* bm = P.in[5];
    for (int i = gtid; i < 9 * 6144; i += gthreads) { float s = bm[i % 6144];
        for (int ks = 0; ks < KSPLIT; ++ks) s += mp[(size_t)ks * 9 * 6144 + i];
        mod[i] = s; }
}

__device__ __forceinline__ void transpose_item(const float* W, int ldw, bf16* WT, int ldt, int k0, int n0, int dst_row0, float* scr, int lane) {
#pragma unroll 8
    for (int i = 0; i < 32; ++i) { const int kk = 2 * i + (lane >> 5); scr[kk * 33 + (lane & 31)] = W[(size_t)(k0 + kk) * ldw + n0 + (lane & 31)]; }
    asm volatile("s_waitcnt lgkmcnt(0)" ::: "memory");
    const int c = lane & 7;
#pragma unroll
    for (int j = 0; j < 4; ++j) { const int n = (lane >> 3) + 8 * j; const float* s = scr + (8 * c) * 33 + n;
        u32x4 o; o.x = pk2(s[0 * 33], s[1 * 33]); o.y = pk2(s[2 * 33], s[3 * 33]); o.z = pk2(s[4 * 33], s[5 * 33]); o.w = pk2(s[6 * 33], s[7 * 33]);
        *(u32x4*)(WT + (size_t)(dst_row0 + n) * ldt + k0 + 8 * c) = o; }
    asm volatile("s_waitcnt lgkmcnt(0)" ::: "memory");
}
constexpr int IT_WIN = 16 * 128, IT_GLU = 8 * 32, IT_SSM = 8 * 32, IT_CONV = 8 * 32, IT_WO = 16 * 32, IT_RT = 16 * 8, IT_SG = 16 * 8, IT_SU = 16 * 8, IT_SD = 4 * 32;
constexpr int IT_DENSE = IT_WIN + IT_GLU + IT_SSM + IT_CONV + IT_WO + IT_RT + IT_SG + IT_SU + IT_SD;
constexpr int IT_EG = 16 * 8, IT_ED = 4 * 32;
constexpr int IT_EXP = NE * (2 * IT_EG + IT_ED);
constexpr int IT_ALL = IT_DENSE + IT_EXP;
__device__ __forceinline__ void wprep_item(const Ptrs& P, int it, float* scr, int lane) {
    unsigned char* ws = P.ws;
    int r = it;
    if (r < IT_WIN) { const int nb = r % 128, kb = r / 128; transpose_item(P.in[8], INC, (bf16*)(ws + WS_WIN_T), D, kb * 64, nb * 32, nb * 32, scr, lane); return; } r -= IT_WIN;
    if (r < IT_GLU) { const int nb = r % 32, kb = r / 32, n0 = nb * 32; const int h = n0 / 512, j0 = n0 % 512;
        transpose_item(P.in[17], 1024, (bf16*)(ws + WS_WGLU_T), 512, kb * 64, n0, 256 * (j0 / 128) + h * 128 + (j0 % 128), scr, lane); return; } r -= IT_GLU;
    if (r < IT_SSM) { const int nb = r % 32, kb = r / 32; transpose_item(P.in[18], 1024, (bf16*)(ws + WS_WSSM_T), 512, kb * 64, nb * 32, nb * 32, scr, lane); return; } r -= IT_SSM;
    if (r < IT_CONV) { const int nb = r % 32, kb = r / 32; transpose_item(P.in[20], 1024, (bf16*)(ws + WS_WCONV_T), 512, kb * 64, nb * 32, nb * 32, scr, lane); return; } r -= IT_CONV;
    if (r < IT_WO) { const int nb = r % 32, kb = r / 32; transpose_item(P.in[21], 1024, (bf16*)(ws + WS_WO_T), 1024, kb * 64, nb * 32, nb * 32, scr, lane); return; } r -= IT_WO;
    if (r < IT_RT) { const int nb = r % 8, kb = r / 8; transpose_item(P.in[22], 256, (bf16*)(ws + WS_WRS_T), 1024, kb * 64, nb * 32, nb * 32, scr, lane); return; } r -= IT_RT;
    if (r < IT_SG) { const int nb = r % 8, kb = r / 8, j0 = nb * 32; transpose_item(P.in[27], 256, (bf16*)(ws + WS_WRS_T), 1024, kb * 64, j0, 256 + 256 * (j0 / 128) + (j0 % 128), scr, lane); return; } r -= IT_SG;
    if (r < IT_SU) { const int nb = r % 8, kb = r / 8, j0 = nb * 32; transpose_item(P.in[28], 256, (bf16*)(ws + WS_WRS_T), 1024, kb * 64, j0, 256 + 256 * (j0 / 128) + 128 + (j0 % 128), scr, lane); return; } r -= IT_SU;
    if (r < IT_SD) { const int nb = r % 32, kb = r / 32; transpose_item(P.in[29], 1024, (bf16*)(ws + WS_WSD_T), 256, kb * 64, nb * 32, nb * 32, scr, lane); return; } r -= IT_SD;
    const int e = r / (2 * IT_EG + IT_ED); r %= (2 * IT_EG + IT_ED);
    if (r < IT_EG) { const int nb = r % 8, kb = r / 8, j0 = nb * 32;
        transpose_item(P.in[24] + (size_t)e * 1024 * 256, 256, (bf16*)(ws + WS_WGU_T) + (size_t)e * 512 * 1024, 1024, kb * 64, j0, 256 * (j0 / 128) + (j0 % 128), scr, lane); return; } r -= IT_EG;
    if (r < IT_EG) { const int nb = r % 8, kb = r / 8, j0 = nb * 32;
        transpose_item(P.in[25] + (size_t)e * 1024 * 256, 256, (bf16*)(ws + WS_WGU_T) + (size_t)e * 512 * 1024, 1024, kb * 64, j0, 256 * (j0 / 128) + 128 + (j0 % 128), scr, lane); return; } r -= IT_EG;
    { const int nb = r % 32, kb = r / 32; transpose_item(P.in[26] + (size_t)e * 256 * 1024, 1024, (bf16*)(ws + WS_WD_T) + (size_t)e * 1024 * 256, 256, kb * 64, nb * 32, nb * 32, scr, lane); }
}

constexpr int SSM_LDS_BYTES = 2 * 64 * 17 * 8 + 2 * 64 * 16 * 8 + 2 * 16 * 64 * 8 + 2 * 16 * 256 * 4;
__device__ __forceinline__ void ssm_tables_item(const Ptrs& P, int g, unsigned char* lds, int t, int nt) {
    float2* apw = (float2*)lds; float2* bb = apw + 2 * 64 * 17; float2* cc = bb + 2 * 64 * 16; float* kt = (float*)(cc + 2 * 16 * 64);
    const float *lre = P.in[9], *lim = P.in[10], *ldt = P.in[11], *bre = P.in[12], *bim = P.in[13], *cre = P.in[14], *cim = P.in[15], *dv = P.in[16];
    __syncthreads();
    for (int i = t; i < 2 * 64; i += nt) { const int d = i / 64, p = i % 64;
        const double dt = exp((double)ldt[d * SG + g]); const double lr = lre[(d * SG + g) * SP + p], li = lim[(d * SG + g) * SP + p];
        for (int n = 0; n <= 16; ++n) { const double mag = exp(lr * dt * n); double ang = li * dt * n; ang -= 6.283185307179586476925 * rint(ang / 6.283185307179586476925);
            apw[(d * 64 + p) * 17 + n] = make_float2((float)(mag * (double)cosf((float)ang)), (float)(mag * (double)sinf((float)ang))); }
        const double ar = (double)apw[(d * 64 + p) * 17 + 1].x, ai = (double)apw[(d * 64 + p) * 17 + 1].y;
        const double den = lr * lr + li * li; const double kr = ((ar - 1.0) * lr + ai * li) / den, ki = (ai * lr - (ar - 1.0) * li) / den;
        for (int c = 0; c < 16; ++c) { const double br = bre[((d * SG + g) * SP + p) * SQ + c], bi = bim[((d * SG + g) * SP + p) * SQ + c];
            bb[(d * 64 + p) * 16 + c] = make_float2((float)(kr * br - ki * bi), (float)(kr * bi + ki * br)); }
        float* a16 = (float*)(P.ws + WS_A16); a16[((g * 2 + d) * 64 + p) * 2 + 0] = apw[(d * 64 + p) * 17 + 16].x; a16[((g * 2 + d) * 64 + p) * 2 + 1] = apw[(d * 64 + p) * 17 + 16].y;
    }
    for (int i = t; i < 2 * 16 * 64; i += nt) { const int d = i / 1024, c = (i / 64) % 16, p = i % 64;
        cc[i] = make_float2(cre[((d * SG + g) * SQ + c) * SP + p], cim[((d * SG + g) * SQ + c) * SP + p]); }
    __syncthreads();
    for (int i = t; i < 2 * 16 * 256; i += nt) { const int d = i / 4096, tau = (i / 256) % 16, c = (i / 16) % 16, c2 = i % 16; float s = 0.f;
        for (int p = 0; p < 64; ++p) { const float2 C = cc[(d * 16 + c) * 64 + p], A = apw[(d * 64 + p) * 17 + tau], B = bb[(d * 64 + p) * 16 + c2];
            const float abr = A.x * B.x - A.y * B.y, abi = A.x * B.y + A.y * B.x; s += C.x * abr - C.y * abi; }
        kt[i] = s; }
    __syncthreads();
    bf16* mg = (bf16*)(P.ws + WS_MG) + (size_t)g * 256 * 512;
    for (int i = t; i < 256 * 512; i += nt) { const int n = i / 512, k = i % 512, tt = n / 16, c = n % 16; float v;
        if (k < 256) { const int s = k / 16, c2 = k % 16;
            if (tt > s) v = kt[((0 * 16) + (tt - s)) * 256 + c * 16 + c2];
            else if (tt < s) v = kt[((1 * 16) + (s - tt)) * 256 + c * 16 + c2];
            else v = kt[c * 16 + c2] + kt[16 * 256 + c * 16 + c2] + (c == c2 ? dv[g * 16 + c] : 0.f);
        } else { const int kk = k - 256, d = kk / 128, part = (kk / 64) & 1, p = kk % 64;
            const float2 C = cc[(d * 16 + c) * 64 + p], A = apw[(d * 64 + p) * 17 + (d == 0 ? tt + 1 : 16 - tt)];
            v = part == 0 ? (C.x * A.x - C.y * A.y) : -(C.x * A.y + C.y * A.x); }
        mg[i] = (bf16)f2bf(v); }
    bf16* wi = (bf16*)(P.ws + WS_WINS) + (size_t)g * 2 * 128 * 256;
    for (int i = t; i < 2 * 128 * 256; i += nt) { const int d = i / (128 * 256), n = (i / 256) % 128, k = i % 256, s = k / 16, c2 = k % 16, p = n % 64;
        const float2 A = apw[(d * 64 + p) * 17 + (d == 0 ? 15 - s : s)], B = bb[(d * 64 + p) * 16 + c2];
        const float v = n < 64 ? (A.x * B.x - A.y * B.y) : (A.x * B.y + A.y * B.x);
        wi[i] = (bf16)f2bf(v); }
}

__device__ __forceinline__ void norm_mod_row(const float* xrow, const float* gam, const float* sc, const float* sh, bf16* orow, int lane) {
    const f32x4* xr = (const f32x4*)xrow + lane; f32x4 v[4]; float s = 0.f;
#pragma unroll
    for (int j = 0; j < 4; ++j) { v[j] = xr[64 * j]; s += (v[j].x * v[j].x + v[j].y * v[j].y) + (v[j].z * v[j].z + v[j].w * v[j].w); }
    const float r = rsqrtf(wave_sum(s) * (1.f / D) + EPS);
    unsigned long long* o8 = (unsigned long long*)orow + lane;
#pragma unroll
    for (int j = 0; j < 4; ++j) { const f32x4 g4 = ((const f32x4*)gam)[lane + 64 * j], s4 = ((const f32x4*)sc)[lane + 64 * j], h4 = ((const f32x4*)sh)[lane + 64 * j];
        const float a = v[j].x * r * g4.x * (1.f + s4.x) + h4.x, b = v[j].y * r * g4.y * (1.f + s4.y) + h4.y, c = v[j].z * r * g4.z * (1.f + s4.z) + h4.z, d = v[j].w * r * g4.w * (1.f + s4.w) + h4.w;
        o8[64 * j] = (unsigned long long)pk2(a, b) | ((unsigned long long)pk2(c, d) << 32); }
}

template <bool PAIR, class F>
__global__ void __launch_bounds__(256) ngemm(F f, const bf16* Bt, long ldb, long strideBz, int K) {
    const int z = blockIdx.z, tid = threadIdx.x, w = tid >> 6, lane = tid & 63, fr = lane & 15, fq = lane >> 4;
    const int Mz = f.mcount(z);
    const int bx = blockIdx.x;
    const int n0 = PAIR ? (bx / 4) * 256 + (bx % 4) * 32 : bx * 64;
    const bf16* B = Bt + (size_t)f.bz(z) * strideBz;
    for (int mt = blockIdx.y; mt * 64 < Mz; mt += gridDim.y) {
        const int mb = mt * 64 + w * 16;
        int mr = mb + fr; if (mr > Mz - 1) mr = Mz - 1;
        const bf16* arow = f.arow(z, mr);
        f32x4 acc[4];
#pragma unroll
        for (int j = 0; j < 4; ++j) acc[j] = (f32x4){0.f, 0.f, 0.f, 0.f};
        for (int k0 = 0; k0 < K; k0 += 32) {
            const bf16x8 a = *(const bf16x8*)(arow + k0 + fq * 8);
#pragma unroll
            for (int j = 0; j < 4; ++j) { const int nc = n0 + (PAIR ? (j & 1) * 16 + (j >> 1) * 128 : j * 16) + fr;
                const bf16x8 b = *(const bf16x8*)(B + (size_t)nc * ldb + k0 + fq * 8);
                acc[j] = __builtin_amdgcn_mfma_f32_16x16x32_bf16(a, b, acc[j], 0, 0, 0); }
        }
#pragma unroll
        for (int r = 0; r < 4; ++r) { const int m = mb + fq * 4 + r; if (m >= Mz) continue;
            if (PAIR) {
#pragma unroll
                for (int j = 0; j < 2; ++j) f.epi2(z, m, n0 + j * 16 + fr, acc[j][r], acc[2 + j][r]);
            } else {
#pragma unroll
                for (int j = 0; j < 4; ++j) f.epi(z, m, n0 + j * 16 + fr, acc[j][r]);
            } }
    }
}

struct FProj {
    __device__ int bz(int z) const { return z; }
    unsigned char* ws;
    __device__ int mcount(int) const { return NTOK; }
    __device__ const bf16* arow(int, int m) const { return (const bf16*)(ws + WS_H1) + (size_t)m * D; }
    __device__ void epi(int, int m, int n, float v) const {
        if (n < 512) { const int g = n >> 4, c = n & 15, b = m / SEQ, l = m % SEQ;
            ((bf16*)(ws + WS_AG))[((size_t)g * 1024 + b * NCH + l / CT) * 512 + (l % CT) * 16 + c] = (bf16)f2bf(v); }
        else if (n < 2048) ((bf16*)(ws + WS_CBV))[(size_t)m * 1536 + (n - 512)] = (bf16)f2bf(v);
        else ((bf16*)(ws + WS_GATES))[(size_t)m * 2048 + (n - 2048)] = (bf16)f2bf(sigmoidf_(v));
    }
    __device__ void epi2(int, int, int, float, float) const {}
};
struct FProjC {
    __device__ int bz(int z) const { return z; }
    unsigned char* ws;
    __device__ int mcount(int) const { return NCTX; }
    __device__ const bf16* arow(int, int m) const { return (const bf16*)(ws + WS_H1) + (size_t)(NTOK + m) * D; }
    __device__ void epi(int, int m, int n, float v) const { const int g = n >> 4, c = n & 15, b = m / CTXL, l = m % CTXL;
        ((bf16*)(ws + WS_UC))[((size_t)g * 128 + b * NCHC + l / CT) * 256 + (l % CT) * 16 + c] = (bf16)f2bf(v); }
    __device__ void epi2(int, int, int, float, float) const {}
};
struct FSloc {
    unsigned char* ws;
    __device__ int bz(int z) const { return z >> 3; }
    __device__ int mcount(int) const { return NCHT; }
    __device__ const bf16* arow(int z, int m) const { const int b = z & 7, g = z >> 4;
        return m < NCHC ? (const bf16*)(ws + WS_UC) + ((size_t)g * 128 + b * NCHC + m) * 256 : (const bf16*)(ws + WS_AG) + ((size_t)g * 1024 + b * NCH + (m - NCHC)) * 512; }
    __device__ void epi(int z, int m, int n, float v) const { ((float*)(ws + WS_SLOC))[((size_t)z * NCHT + m) * 128 + n] = v; }
    __device__ void epi2(int, int, int, float, float) const {}
};
struct FSsmOut {
    __device__ int bz(int z) const { return z; }
    unsigned char* ws;
    __device__ int mcount(int) const { return 1024; }
    __device__ const bf16* arow(int z, int m) const { return (const bf16*)(ws + WS_AG) + ((size_t)z * 1024 + m) * 512; }
    __device__ void epi(int z, int m, int n, float v) const { const int b = m / NCH, ch = m % NCH, tt = n >> 4, c = n & 15;
        ((bf16*)(ws + WS_YG))[((size_t)b * SEQ + ch * CT + tt) * 512 + z * 16 + c] = (bf16)f2bf(gelu_tanh(v)); }
    __device__ void epi2(int, int, int, float, float) const {}
};
struct FGlu {
    __device__ int bz(int z) const { return z; }
    unsigned char* ws;
    __device__ int mcount(int) const { return NTOK; }
    __device__ const bf16* arow(int, int m) const { return (const bf16*)(ws + WS_YG) + (size_t)m * 512; }
    __device__ void epi(int, int, int, float) const {}
    __device__ void epi2(int, int m, int n, float a, float b) const { ((bf16*)(ws + WS_GLU))[(size_t)m * 512 + (n >> 8) * 128 + (n & 255)] = (bf16)f2bf(a * sigmoidf_(b)); }
};
struct FMergeA {
    __device__ int bz(int z) const { return z; }
    unsigned char* ws;
    __device__ int mcount(int) const { return NTOK; }
    __device__ const bf16* arow(int, int m) const { return (const bf16*)(ws + WS_GLU) + (size_t)m * 512; }
    __device__ void epi(int, int m, int n, float v) const { const float ga = bf2f(((const bf16*)(ws + WS_GATES))[(size_t)m * 2048 + n]);
        ((bf16*)(ws + WS_MERGED))[(size_t)m * 1024 + n] = (bf16)f2bf(ga * v); }
    __device__ void epi2(int, int, int, float, float) const {}
};
struct FMergeB {
    __device__ int bz(int z) const { return z; }
    unsigned char* ws;
    __device__ int mcount(int) const { return NTOK; }
    __device__ const bf16* arow(int, int m) const { return (const bf16*)(ws + WS_CBR) + (size_t)m * 512; }
    __device__ void epi(int, int m, int n, float v) const { const float gb = bf2f(((const bf16*)(ws + WS_GATES))[(size_t)m * 2048 + 1024 + n]);
        bf16* o = (bf16*)(ws + WS_MERGED) + (size_t)m * 1024 + n; *o = (bf16)f2bf(bf2f(*o) + gb * v); }
    __device__ void epi2(int, int, int, float, float) const {}
};
struct FWo {
    __device__ int bz(int z) const { return z; }
    unsigned char* ws; const float* x;
    __device__ int mcount(int) const { return NTOK; }
    __device__ const bf16* arow(int, int m) const { return (const bf16*)(ws + WS_MERGED) + (size_t)m * 1024; }
    __device__ void epi(int, int m, int n, float v) const { const float g1 = ((const float*)(ws + WS_MOD))[(m / SEQ) * 6144 + 2048 + n];
        ((float*)(ws + WS_XL1))[(size_t)m * D + n] = x[(size_t)m * D + n] + g1 * v; }
    __device__ void epi2(int, int, int, float, float) const {}
};
struct FRouter {
    __device__ int bz(int z) const { return z; }
    unsigned char* ws;
    __device__ int mcount(int) const { return NTOK; }
    __device__ const bf16* arow(int, int m) const { return (const bf16*)(ws + WS_H2) + (size_t)m * D; }
    __device__ void epi(int, int m, int n, float v) const { ((float*)(ws + WS_SCORES))[(size_t)m * 256 + n] = sigmoidf_(v); }
    __device__ void epi2(int, int, int, float, float) const {}
};
struct FShared {
    __device__ int bz(int z) const { return z; }
    unsigned char* ws;
    __device__ int mcount(int) const { return NTOK; }
    __device__ const bf16* arow(int, int m) const { return (const bf16*)(ws + WS_H2) + (size_t)m * D; }
    __device__ void epi(int, int, int, float) const {}
    __device__ void epi2(int, int m, int n, float a, float b) const { ((bf16*)(ws + WS_HS))[(size_t)m * 256 + (n >> 8) * 128 + (n & 255)] = (bf16)f2bf(siluf_(a) * b); }
};
struct FSharedDown {
    __device__ int bz(int z) const { return z; }
    unsigned char* ws;
    __device__ int mcount(int) const { return NTOK; }
    __device__ const bf16* arow(int, int m) const { return (const bf16*)(ws + WS_HS) + (size_t)m * 256; }
    __device__ void epi(int, int m, int n, float v) const { const float g2 = ((const float*)(ws + WS_MOD))[(m / SEQ) * 6144 + 5120 + n];
        ((float*)(ws + WS_XL1))[(size_t)m * D + n] += g2 * v; }
    __device__ void epi2(int, int, int, float, float) const {}
};
struct FMoe1 {
    __device__ int bz(int z) const { return z; }
    unsigned char* ws;
    __device__ int mcount(int z) const { return (int)((const unsigned*)(ws + WS_CTL))[CW_CNT + z]; }
    __device__ const bf16* arow(int z, int m) const { const int ts = ((const int*)(ws + WS_LIST))[(size_t)z * LIST_CAP + m]; return (const bf16*)(ws + WS_H2) + (size_t)(ts >> 3) * D; }
    __device__ void epi(int, int, int, float) const {}
    __device__ void epi2(int z, int m, int n, float a, float b) const { const int st = ((const int*)(ws + WS_START))[z];
        ((bf16*)(ws + WS_HBUF))[(size_t)(st + m) * 256 + (n >> 8) * 128 + (n & 255)] = (bf16)f2bf(siluf_(a) * b); }
};
struct FMoe2 {
    __device__ int bz(int z) const { return z; }
    unsigned char* ws;
    __device__ int mcount(int z) const { return (int)((const unsigned*)(ws + WS_CTL))[CW_CNT + z]; }
    __device__ const bf16* arow(int z, int m) const { const int st = ((const int*)(ws + WS_START))[z]; return (const bf16*)(ws + WS_HBUF) + (size_t)(st + m) * 256; }
    __device__ void epi(int z, int m, int n, float v) const { const int ts = ((const int*)(ws + WS_LIST))[(size_t)z * LIST_CAP + m]; const float w = ((const float*)(ws + WS_TW))[ts];
        ((bf16*)(ws + WS_YSLOT))[(size_t)ts * D + n] = (bf16)f2bf(w * v); }
    __device__ void epi2(int, int, int, float, float) const {}
};

__global__ void __launch_bounds__(256) k_mod_partial(Ptrs P) { __shared__ float sil[9 * 64]; for (int it = blockIdx.x; it < 24 * KSPLIT; it += gridDim.x) mod_partial_item(P, it, threadIdx.x, sil); }
__global__ void __launch_bounds__(256) k_mod_reduce(Ptrs P) { mod_reduce(P, blockIdx.x * blockDim.x + threadIdx.x, gridDim.x * blockDim.x); }
__global__ void __launch_bounds__(256) k_wprep(Ptrs P) {
    __shared__ float scr[4][64 * 33];
    const int w = threadIdx.x >> 6, lane = threadIdx.x & 63;
    for (int it = blockIdx.x * 4 + w; it < IT_ALL; it += gridDim.x * 4) wprep_item(P, it, scr[w], lane);
}
__global__ void __launch_bounds__(256) k_ssmtab(Ptrs P) { extern __shared__ __attribute__((aligned(16))) unsigned char lds[]; ssm_tables_item(P, blockIdx.x, lds, threadIdx.x, blockDim.x); }
__global__ void __launch_bounds__(256) k_h1(Ptrs P) {
    const int lane = threadIdx.x & 63; const int gw = blockIdx.x * 4 + (threadIdx.x >> 6), ngw = gridDim.x * 4;
    const float* mod = (const float*)(P.ws + WS_MOD);
    for (int r = gw; r < NROW; r += ngw) {
        const bool lat = r < NTOK; const int mr = lat ? r / SEQ : 8;
        const float* xrow = lat ? P.in[0] + (size_t)r * D : P.in[2] + (size_t)(r - NTOK) * D;
        norm_mod_row(xrow, P.in[6], mod + mr * 6144 + 1024, mod + mr * 6144 + 0, (bf16*)(P.ws + WS_H1) + (size_t)r * D, lane);
    }
}
__global__ void __launch_bounds__(256) k_h2(Ptrs P) {
    const int lane = threadIdx.x & 63; const int gw = blockIdx.x * 4 + (threadIdx.x >> 6), ngw = gridDim.x * 4;
    const float* mod = (const float*)(P.ws + WS_MOD);
    for (int r = gw; r < NTOK; r += ngw) { const int b = r / SEQ;
        norm_mod_row((const float*)(P.ws + WS_XL1) + (size_t)r * D, P.in[7], mod + b * 6144 + 4096, mod + b * 6144 + 3072, (bf16*)(P.ws + WS_H2) + (size_t)r * D, lane); }
}
__global__ void __launch_bounds__(256) k_conv(Ptrs P) {
    const bf16* cbv = (const bf16*)(P.ws + WS_CBV); bf16* cbr = (bf16*)(P.ws + WS_CBR); const float* cw = P.in[19];
    const size_t total = (size_t)NTOK * 512;
    for (size_t i = (size_t)blockIdx.x * blockDim.x + threadIdx.x; i < total; i += (size_t)gridDim.x * blockDim.x) {
        const int tok = (int)(i / 512), j = (int)(i % 512), col = tok & 63;
        const bf16* r = cbv + (size_t)tok * 1536;
        float acc = cw[512 + j] * bf2f(r[512 + j]) * bf2f(r[1024 + j]);
        if (col > 0) acc += cw[j] * bf2f(r[512 + j - 1536]) * bf2f(r[1024 + j - 1536]);
        if (col < 63) acc += cw[1024 + j] * bf2f(r[512 + j + 1536]) * bf2f(r[1024 + j + 1536]);
        cbr[i] = (bf16)f2bf(bf2f(r[j]) * acc);
    }
}
__global__ void __launch_bounds__(256) k_scan(Ptrs P) {
    const int i = blockIdx.x * blockDim.x + threadIdx.x; if (i >= SG * 2 * NB * SP) return;
    const int p = i % 64, b = (i / 64) % 8, d = (i / 512) % 2, g = i / 1024;
    const float* a16 = (const float*)(P.ws + WS_A16); const float ar = a16[((g * 2 + d) * 64 + p) * 2], ai = a16[((g * 2 + d) * 64 + p) * 2 + 1];
    const float* sl = (const float*)(P.ws + WS_SLOC) + (size_t)((g * 2 + d) * 8 + b) * NCHT * 128;
    bf16* ag = (bf16*)(P.ws + WS_AG) + ((size_t)g * 1024 + b * NCH) * 512 + 256 + d * 128;
    float sr = 0.f, si = 0.f;
    if (d == 0) {
        for (int k = 0; k < NCHC; ++k) { const float lr = sl[k * 128 + p], li = sl[k * 128 + 64 + p]; const float nr = ar * sr - ai * si + lr, ni = ar * si + ai * sr + li; sr = nr; si = ni; }
        for (int k = 0; k < NCH; ++k) { ag[(size_t)k * 512 + p] = (bf16)f2bf(sr); ag[(size_t)k * 512 + 64 + p] = (bf16)f2bf(si);
            const float lr = sl[(NCHC + k) * 128 + p], li = sl[(NCHC + k) * 128 + 64 + p]; const float nr = ar * sr - ai * si + lr, ni = ar * si + ai * sr + li; sr = nr; si = ni; }
    } else {
        for (int k = NCHC - 1; k >= 0; --k) { const float lr = sl[k * 128 + p], li = sl[k * 128 + 64 + p]; const float nr = ar * sr - ai * si + lr, ni = ar * si + ai * sr + li; sr = nr; si = ni; }
        for (int k = NCH - 1; k >= 0; --k) { ag[(size_t)k * 512 + p] = (bf16)f2bf(sr); ag[(size_t)k * 512 + 64 + p] = (bf16)f2bf(si);
            const float lr = sl[(NCHC + k) * 128 + p], li = sl[(NCHC + k) * 128 + 64 + p]; const float nr = ar * sr - ai * si + lr, ni = ar * si + ai * sr + li; sr = nr; si = ni; }
    }
}
__device__ __forceinline__ void route_token(const Ptrs& P, int tok, int lane) {
    const f32x4 sc = ((const f32x4*)((const float*)(P.ws + WS_SCORES) + (size_t)tok * 256))[lane];
    const f32x4 bi = ((const f32x4*)P.in[23])[lane];
    float c0 = sc.x + bi.x, c1 = sc.y + bi.y, c2 = sc.z + bi.z, c3 = sc.w + bi.w;
    float t1 = fmaxf(c0, c1), t2 = fminf(c0, c1);
    { const float a = fmaxf(c2, c3), b = fminf(c2, c3); const float n1 = fmaxf(t1, a); const float n2 = fmaxf(fminf(t1, a), fmaxf(t2, b)); t1 = n1; t2 = n2; }
#pragma unroll
    for (int o = 1; o < 8; o <<= 1) { const float a = __shfl_xor(t1, o), b = __shfl_xor(t2, o); const float n1 = fmaxf(t1, a); const float n2 = fmaxf(fminf(t1, a), fmaxf(t2, b)); t1 = n1; t2 = n2; }
    const float gs = t1 + t2; const int myg = lane >> 3; int rank = 0;
#pragma unroll
    for (int j = 0; j < 8; ++j) { const float o = __shfl(gs, j * 8); rank += (o > gs || (o == gs && j < myg)) ? 1 : 0; }
    if (rank >= 4) { c0 = c1 = c2 = c3 = -INFINITY; }
    int sel_e = 0; float sel_s = 0.f; float ssum = 0.f;
#pragma unroll
    for (int k = 0; k < 8; ++k) {
        float bv = c0, bs = sc.x; int be = lane * 4;
        if (c1 > bv) { bv = c1; bs = sc.y; be = lane * 4 + 1; }
        if (c2 > bv) { bv = c2; bs = sc.z; be = lane * 4 + 2; }
        if (c3 > bv) { bv = c3; bs = sc.w; be = lane * 4 + 3; }
#pragma unroll
        for (int o = 1; o < 64; o <<= 1) { const float ov = __shfl_xor(bv, o), os = __shfl_xor(bs, o); const int oe = __shfl_xor(be, o);
            if (ov > bv || (ov == bv && oe < be)) { bv = ov; bs = os; be = oe; } }
        if (lane == k) { sel_e = be; sel_s = bs; }
        ssum += bs;
        if ((be >> 2) == lane) { const int q = be & 3; if (q == 0) c0 = -INFINITY; else if (q == 1) c1 = -INFINITY; else if (q == 2) c2 = -INFINITY; else c3 = -INFINITY; }
    }
    if (lane < 8) {
        const float w = sel_s / ssum * 2.5f;
        unsigned* cnt = (unsigned*)(P.ws + WS_CTL) + CW_CNT;
        const unsigned rk = atomicAdd(&cnt[sel_e], 1u);
        ((int*)(P.ws + WS_LIST))[(size_t)sel_e * LIST_CAP + rk] = tok * 8 + lane;
        ((float*)(P.ws + WS_TW))[tok * 8 + lane] = w;
    }
}
__global__ void __launch_bounds__(256) k_route(Ptrs P) {
    const int lane = threadIdx.x & 63; const int gw = blockIdx.x * 4 + (threadIdx.x >> 6), ngw = gridDim.x * 4;
    for (int tok = gw; tok < NTOK; tok += ngw) route_token(P, tok, lane);
}
__global__ void k_start(Ptrs P) {
    if (threadIdx.x == 0) { const unsigned* cnt = (const unsigned*)(P.ws + WS_CTL) + CW_CNT; int* st = (int*)(P.ws + WS_START); int s = 0;
        for (int e = 0; e < NE; ++e) { st[e] = s; s += ((int)cnt[e] + 255) & ~255; } st[NE] = s; }
}
__global__ void __launch_bounds__(256) k_final(Ptrs P) {
    const int lane = threadIdx.x & 63; const int gw = blockIdx.x * 4 + (threadIdx.x >> 6), ngw = gridDim.x * 4;
    const float* mod = (const float*)(P.ws + WS_MOD);
    for (int r = gw; r < NTOK; r += ngw) { const int b = r / SEQ;
        const f32x4* xr = (const f32x4*)((const float*)(P.ws + WS_XL1) + (size_t)r * D) + lane; f32x4 v[4]; float s = 0.f;
#pragma unroll
        for (int j = 0; j < 4; ++j) { f32x4 acc = (f32x4){0.f, 0.f, 0.f, 0.f};
            for (int k = 0; k < 8; ++k) { const u32x2 y = ((const u32x2*)((const bf16*)(P.ws + WS_YSLOT) + (size_t)(r * 8 + k) * D))[lane + 64 * j];
                acc.x += bf2f(y.x); acc.y += bf2f(y.x >> 16); acc.z += bf2f(y.y); acc.w += bf2f(y.y >> 16); }
            const f32x4 g2 = ((const f32x4*)(mod + b * 6144 + 5120))[lane + 64 * j];
            v[j] = xr[64 * j] + g2 * acc; s += (v[j].x * v[j].x + v[j].y * v[j].y) + (v[j].z * v[j].z + v[j].w * v[j].w); }
        const float rr = rsqrtf(wave_sum(s) * (1.f / D) + EPS);
        f32x4* o = (f32x4*)(P.out + (size_t)r * D) + lane;
#pragma unroll
        for (int j = 0; j < 4; ++j) { const f32x4 fg = ((const f32x4*)P.in[30])[lane + 64 * j]; o[64 * j] = v[j] * rr * fg; }
    }
}

extern "C" void kernel_launch(void* const* d_in, const int* in_sizes, int n_in, void* d_out, int out_size, void* d_ws, size_t ws_size, hipStream_t stream) {
    if (n_in != 31 || out_size != NTOK * D || ws_size < WS_END) { fprintf(stderr, "kernel_launch: unexpected problem (n_in %d, out %d, ws %zu)\n", n_in, out_size, ws_size); return; }
    Ptrs P{};
    for (int i = 0; i < 31; ++i) P.in[i] = (const float*)d_in[i];
    P.out = (float*)d_out; P.ws = (unsigned char*)d_ws;
    unsigned char* ws = P.ws;
    (void)hipMemsetAsync(ws + WS_CTL, 0, MiB, stream);
    k_mod_partial<<<24 * KSPLIT, 256, 0, stream>>>(P);
    k_mod_reduce<<<54, 256, 0, stream>>>(P);
    k_wprep<<<2048, 256, 0, stream>>>(P);
    static bool attr_done = false;
    if (!attr_done) { (void)hipFuncSetAttribute((const void*)k_ssmtab, hipFuncAttributeMaxDynamicSharedMemorySize, SSM_LDS_BYTES); attr_done = true; }
    k_ssmtab<<<SG, 256, SSM_LDS_BYTES, stream>>>(P);
    k_h1<<<2048, 256, 0, stream>>>(P);
    ngemm<false, FProj><<<dim3(INC / 64, 64, 1), 256, 0, stream>>>(FProj{ws}, (const bf16*)(ws + WS_WIN_T), D, 0, D);
    ngemm<false, FProjC><<<dim3(512 / 64, 32, 1), 256, 0, stream>>>(FProjC{ws}, (const bf16*)(ws + WS_WIN_T), D, 0, D);
    k_conv<<<4096, 256, 0, stream>>>(P);
    ngemm<false, FSloc><<<dim3(2, 3, SG * 2 * NB), 256, 0, stream>>>(FSloc{ws}, (const bf16*)(ws + WS_WINS), 256, (long)128 * 256, 256);
    k_scan<<<(SG * 2 * NB * SP) / 256, 256, 0, stream>>>(P);
    ngemm<false, FSsmOut><<<dim3(4, 16, SG), 256, 0, stream>>>(FSsmOut{ws}, (const bf16*)(ws + WS_MG), 512, 256 * 512, 512);
    ngemm<true, FGlu><<<dim3(16, 64, 1), 256, 0, stream>>>(FGlu{ws}, (const bf16*)(ws + WS_WGLU_T), 512, 0, 512);
    ngemm<false, FMergeA><<<dim3(16, 64, 1), 256, 0, stream>>>(FMergeA{ws}, (const bf16*)(ws + WS_WSSM_T), 512, 0, 512);
    ngemm<false, FMergeB><<<dim3(16, 64, 1), 256, 0, stream>>>(FMergeB{ws}, (const bf16*)(ws + WS_WCONV_T), 512, 0, 512);
    ngemm<false, FWo><<<dim3(16, 64, 1), 256, 0, stream>>>(FWo{ws, P.in[0]}, (const bf16*)(ws + WS_WO_T), 1024, 0, 1024);
    k_h2<<<2048, 256, 0, stream>>>(P);
    ngemm<false, FRouter><<<dim3(4, 64, 1), 256, 0, stream>>>(FRouter{ws}, (const bf16*)(ws + WS_WRS_T), 1024, 0, 1024);
    ngemm<true, FShared><<<dim3(8, 64, 1), 256, 0, stream>>>(FShared{ws}, (const bf16*)(ws + WS_WRS_T) + (size_t)256 * 1024, 1024, 0, 1024);
    k_route<<<1024, 256, 0, stream>>>(P);
    k_start<<<1, 64, 0, stream>>>(P);
    ngemm<false, FSharedDown><<<dim3(16, 64, 1), 256, 0, stream>>>(FSharedDown{ws}, (const bf16*)(ws + WS_WSD_T), 256, 0, 256);
    ngemm<true, FMoe1><<<dim3(8, 4, NE), 256, 0, stream>>>(FMoe1{ws}, (const bf16*)(ws + WS_WGU_T), 1024, (long)512 * 1024, 1024);
    ngemm<false, FMoe2><<<dim3(16, 4, NE), 256, 0, stream>>>(FMoe2{ws}, (const bf16*)(ws + WS_WD_T), 256, (long)1024 * 256, 256);
    k_final<<<2048, 256, 0, stream>>>(P);
}
```

```cpp
#include <hip/hip_runtime.h>
#include <cstdio>
#include <cstdint>

typedef unsigned short bf16;
typedef short bf16x8 __attribute__((ext_vector_type(8)));
typedef float f32x4 __attribute__((ext_vector_type(4)));
typedef unsigned u32x4 __attribute__((ext_vector_type(4)));
typedef unsigned u32x2 __attribute__((ext_vector_type(2)));

constexpr int D = 1024, NB = 8, SEQ = 2048, CTXL = 256;
constexpr int NTOK = NB * SEQ, NCTX = NB * CTXL, NROW = NTOK + NCTX;
constexpr int INC = 4096, SG = 32, SP = 64, SQ = 16, CT = 16;
constexpr int NCH = SEQ / CT, NCHC = CTXL / CT, NCHT = NCH + NCHC;
constexpr int NE = 256, TOPK = 8, ED = 256;
constexpr float EPS = 1e-6f;
constexpr int KSPLIT = 16;
constexpr int LIST_CAP = NTOK;
constexpr int HB_ROWS = NTOK * TOPK + NE * 256;

constexpr size_t MiB = 1u << 20;
constexpr size_t WS_CTL = 0;
constexpr size_t WS_MODP = 1 * MiB;
constexpr size_t WS_MOD = 5 * MiB;
constexpr size_t WS_A16 = 5 * MiB + 512 * 1024;
constexpr size_t WS_START = 5 * MiB + 600 * 1024;
constexpr size_t WS_WIN_T = 6 * MiB;
constexpr size_t WS_WGLU_T = 14 * MiB;
constexpr size_t WS_WSSM_T = 15 * MiB;
constexpr size_t WS_WCONV_T = 16 * MiB;
constexpr size_t WS_WO_T = 17 * MiB;
constexpr size_t WS_WRS_T = 19 * MiB;
constexpr size_t WS_WSD_T = 21 * MiB;
constexpr size_t WS_MG = 22 * MiB;
constexpr size_t WS_WINS = 30 * MiB;
constexpr size_t WS_WGU_T = 34 * MiB;
constexpr size_t WS_WD_T = 290 * MiB;
constexpr size_t WS_H1 = 418 * MiB;
constexpr size_t WS_AG = 454 * MiB;
constexpr size_t WS_UC = 486 * MiB;
constexpr size_t WS_SLOC = 488 * MiB;
constexpr size_t WS_CBV = 524 * MiB;
constexpr size_t WS_GATES = 572 * MiB;
constexpr size_t WS_CBR = 636 * MiB;
constexpr size_t WS_YG = 652 * MiB;
constexpr size_t WS_GLU = 668 * MiB;
constexpr size_t WS_MERGED = 684 * MiB;
constexpr size_t WS_YSLOT = 418 * MiB;
constexpr size_t WS_XL1 = 716 * MiB;
constexpr size_t WS_H2 = 780 * MiB;
constexpr size_t WS_SCORES = 812 * MiB;
constexpr size_t WS_HS = 828 * MiB;
constexpr size_t WS_TW = 836 * MiB;
constexpr size_t WS_LIST = 838 * MiB;
constexpr size_t WS_HBUF = 854 * MiB;
constexpr size_t WS_END = 950 * MiB;
constexpr int CW_CNT = 0;

__device__ __forceinline__ unsigned f2bf(float f) { unsigned u = __builtin_bit_cast(unsigned, f); return (u + 0x7fffu + ((u >> 16) & 1u)) >> 16; }
__device__ __forceinline__ unsigned pk2(float lo, float hi) { return f2bf(lo) | (f2bf(hi) << 16); }
__device__ __forceinline__ float bf2f(unsigned h) { return __builtin_bit_cast(float, (h & 0xffffu) << 16); }
__device__ __forceinline__ float sigmoidf_(float v) { return 1.0f / (1.0f + __expf(-v)); }
__device__ __forceinline__ float siluf_(float v) { return v / (1.0f + __expf(-v)); }
__device__ __forceinline__ float gelu_tanh(float v) { const float u = 0.7978845608028654f * (v + 0.044715f * v * v * v); return 0.5f * v * (1.0f + tanhf(u)); }
__device__ __forceinline__ float wave_sum(float v) {
#pragma unroll
    for (int o = 1; o < 64; o <<= 1) v += __shfl_xor(v, o);
    return v;
}

struct Ptrs {
    const float* in[31];
    float* out;
    unsigned char* ws;
};

__device__ __forceinline__ void mod_cols(const Ptrs& P, int cb, float* sil, int t, int nt) {
    float* part = sil + 9 * 1024;
    const float* c = P.in[1]; const float* cc = P.in[3]; const float* wm = P.in[4]; const float* bm = P.in[5];
    __syncthreads();
    for (int i = t; i < 9 * 1024; i += nt) { const int r = i >> 10, k = i & 1023; const float v = r < 8 ? c[r * D + k] : cc[k]; sil[i] = siluf_(v); }
    __syncthreads();
    if (t < 504) { const int col = t % 24, ks = t / 24; const int k0 = ks * 49, k1 = (k0 + 49 < 1024) ? k0 + 49 : 1024;
        float acc[9];
#pragma unroll
        for (int r = 0; r < 9; ++r) acc[r] = 0.f;
        for (int k = k0; k < k1; ++k) { const float w = wm[(size_t)k * 6144 + cb * 24 + col];
#pragma unroll
            for (int r = 0; r < 9; ++r) acc[r] += sil[r * 1024 + k] * w; }
#pragma unroll
        for (int r = 0; r < 9; ++r) part[(ks * 24 + col) * 9 + r] = acc[r]; }
    __syncthreads();
    if (t < 216) { const int r = t / 24, col = t % 24; float s = bm[cb * 24 + col];
        for (int ks = 0; ks < 21; ++ks) s += part[(ks * 24 + col) * 9 + r];
        ((float*)(P.ws + WS_MOD))[r * 6144 + cb * 24 + col] = s; }
    __syncthreads();
}

__device__ __forceinline__ void transpose_item(const float* W, int ldw, bf16* WT, int ldt, int k0, int n0, int dst_row0, float* scr, int lane) {
#pragma unroll 8
    for (int i = 0; i < 32; ++i) { const int kk = 2 * i + (lane >> 5); scr[kk * 33 + (lane & 31)] = W[(size_t)(k0 + kk) * ldw + n0 + (lane & 31)]; }
    asm volatile("s_waitcnt lgkmcnt(0)" ::: "memory");
    const int c = lane & 7;
#pragma unroll
    for (int j = 0; j < 4; ++j) { const int n = (lane >> 3) + 8 * j; const float* s = scr + (8 * c) * 33 + n;
        u32x4 o; o.x = pk2(s[0 * 33], s[1 * 33]); o.y = pk2(s[2 * 33], s[3 * 33]); o.z = pk2(s[4 * 33], s[5 * 33]); o.w = pk2(s[6 * 33], s[7 * 33]);
        *(u32x4*)(WT + (size_t)(dst_row0 + n) * ldt + k0 + 8 * c) = o; }
    asm volatile("s_waitcnt lgkmcnt(0)" ::: "memory");
}
constexpr int IT_WIN = 16 * 128, IT_GLU = 8 * 32, IT_SSM = 8 * 32, IT_CONV = 8 * 32, IT_WO = 16 * 32, IT_RT = 16 * 8, IT_SG = 16 * 8, IT_SU = 16 * 8, IT_SD = 4 * 32;
constexpr int IT_DENSE = IT_WIN + IT_GLU + IT_SSM + IT_CONV + IT_WO + IT_RT + IT_SG + IT_SU + IT_SD;
constexpr int IT_EG = 16 * 8, IT_ED = 4 * 32;
constexpr int IT_EXP = NE * (2 * IT_EG + IT_ED);
constexpr int IT_ALL = IT_DENSE + IT_EXP;
__device__ __forceinline__ void wprep_item(const Ptrs& P, int it, float* scr, int lane) {
    unsigned char* ws = P.ws;
    int r = it;
    if (r < IT_WIN) { const int nb = r % 128, kb = r / 128; transpose_item(P.in[8], INC, (bf16*)(ws + WS_WIN_T), D, kb * 64, nb * 32, nb * 32, scr, lane); return; } r -= IT_WIN;
    if (r < IT_GLU) { const int nb = r % 32, kb = r / 32, n0 = nb * 32; const int h = n0 / 512, j0 = n0 % 512;
        transpose_item(P.in[17], 1024, (bf16*)(ws + WS_WGLU_T), 512, kb * 64, n0, 256 * (j0 / 128) + h * 128 + (j0 % 128), scr, lane); return; } r -= IT_GLU;
    if (r < IT_SSM) { const int nb = r % 32, kb = r / 32; transpose_item(P.in[18], 1024, (bf16*)(ws + WS_WSSM_T), 512, kb * 64, nb * 32, nb * 32, scr, lane); return; } r -= IT_SSM;
    if (r < IT_CONV) { const int nb = r % 32, kb = r / 32; transpose_item(P.in[20], 1024, (bf16*)(ws + WS_WCONV_T), 512, kb * 64, nb * 32, nb * 32, scr, lane); return; } r -= IT_CONV;
    if (r < IT_WO) { const int nb = r % 32, kb = r / 32; transpose_item(P.in[21], 1024, (bf16*)(ws + WS_WO_T), 1024, kb * 64, nb * 32, nb * 32, scr, lane); return; } r -= IT_WO;
    if (r < IT_RT) { const int nb = r % 8, kb = r / 8; transpose_item(P.in[22], 256, (bf16*)(ws + WS_WRS_T), 1024, kb * 64, nb * 32, nb * 32, scr, lane); return; } r -= IT_RT;
    if (r < IT_SG) { const int nb = r % 8, kb = r / 8, j0 = nb * 32; transpose_item(P.in[27], 256, (bf16*)(ws + WS_WRS_T), 1024, kb * 64, j0, 256 + 256 * (j0 / 128) + (j0 % 128), scr, lane); return; } r -= IT_SG;
    if (r < IT_SU) { const int nb = r % 8, kb = r / 8, j0 = nb * 32; transpose_item(P.in[28], 256, (bf16*)(ws + WS_WRS_T), 1024, kb * 64, j0, 256 + 256 * (j0 / 128) + 128 + (j0 % 128), scr, lane); return; } r -= IT_SU;
    if (r < IT_SD) { const int nb = r % 32, kb = r / 32; transpose_item(P.in[29], 1024, (bf16*)(ws + WS_WSD_T), 256, kb * 64, nb * 32, nb * 32, scr, lane); return; } r -= IT_SD;
    const int e = r / (2 * IT_EG + IT_ED); r %= (2 * IT_EG + IT_ED);
    if (r < IT_EG) { const int nb = r % 8, kb = r / 8, j0 = nb * 32;
        transpose_item(P.in[24] + (size_t)e * 1024 * 256, 256, (bf16*)(ws + WS_WGU_T) + (size_t)e * 512 * 1024, 1024, kb * 64, j0, 256 * (j0 / 128) + (j0 % 128), scr, lane); return; } r -= IT_EG;
    if (r < IT_EG) { const int nb = r % 8, kb = r / 8, j0 = nb * 32;
        transpose_item(P.in[25] + (size_t)e * 1024 * 256, 256, (bf16*)(ws + WS_WGU_T) + (size_t)e * 512 * 1024, 1024, kb * 64, j0, 256 * (j0 / 128) + 128 + (j0 % 128), scr, lane); return; } r -= IT_EG;
    { const int nb = r % 32, kb = r / 32; transpose_item(P.in[26] + (size_t)e * 256 * 1024, 1024, (bf16*)(ws + WS_WD_T) + (size_t)e * 1024 * 256, 256, kb * 64, nb * 32, nb * 32, scr, lane); }
}

constexpr int SSM_LDS_BYTES = 2 * 64 * 17 * 8 + 2 * 64 * 16 * 8 + 2 * 16 * 64 * 8 + 2 * 16 * 256 * 4;
__device__ __forceinline__ void ssm_tables_item(const Ptrs& P, int g, unsigned char* lds, int t, int nt) {
    float2* apw = (float2*)lds; float2* bb = apw + 2 * 64 * 17; float2* cc = bb + 2 * 64 * 16; float* kt = (float*)(cc + 2 * 16 * 64);
    const float *lre = P.in[9], *lim = P.in[10], *ldt = P.in[11], *bre = P.in[12], *bim = P.in[13], *cre = P.in[14], *cim = P.in[15], *dv = P.in[16];
    __syncthreads();
    for (int i = t; i < 2 * 64; i += nt) { const int d = i / 64, p = i % 64;
        const double dt = exp((double)ldt[d * SG + g]); const double lr = lre[(d * SG + g) * SP + p], li = lim[(d * SG + g) * SP + p];
        for (int n = 0; n <= 16; ++n) { const double mag = exp(lr * dt * n); double ang = li * dt * n; ang -= 6.283185307179586476925 * rint(ang / 6.283185307179586476925);
            apw[(d * 64 + p) * 17 + n] = make_float2((float)(mag * (double)cosf((float)ang)), (float)(mag * (double)sinf((float)ang))); }
        const double ar = (double)apw[(d * 64 + p) * 17 + 1].x, ai = (double)apw[(d * 64 + p) * 17 + 1].y;
        const double den = lr * lr + li * li; const double kr = ((ar - 1.0) * lr + ai * li) / den, ki = (ai * lr - (ar - 1.0) * li) / den;
        for (int c = 0; c < 16; ++c) { const double br = bre[((d * SG + g) * SP + p) * SQ + c], bi = bim[((d * SG + g) * SP + p) * SQ + c];
            bb[(d * 64 + p) * 16 + c] = make_float2((float)(kr * br - ki * bi), (float)(kr * bi + ki * br)); }
        float* a16 = (float*)(P.ws + WS_A16); a16[((g * 2 + d) * 64 + p) * 2 + 0] = apw[(d * 64 + p) * 17 + 16].x; a16[((g * 2 + d) * 64 + p) * 2 + 1] = apw[(d * 64 + p) * 17 + 16].y;
    }
    for (int i = t; i < 2 * 16 * 64; i += nt) { const int d = i / 1024, c = (i / 64) % 16, p = i % 64;
        cc[i] = make_float2(cre[((d * SG + g) * SQ + c) * SP + p], cim[((d * SG + g) * SQ + c) * SP + p]); }
    __syncthreads();
    for (int i = t; i < 2 * 16 * 256; i += nt) { const int d = i / 4096, tau = (i / 256) % 16, c = (i / 16) % 16, c2 = i % 16; float s = 0.f;
        for (int p = 0; p < 64; ++p) { const float2 C = cc[(d * 16 + c) * 64 + p], A = apw[(d * 64 + p) * 17 + tau], B = bb[(d * 64 + p) * 16 + c2];
            const float abr = A.x * B.x - A.y * B.y, abi = A.x * B.y + A.y * B.x; s += C.x * abr - C.y * abi; }
        kt[i] = s; }
    __syncthreads();
    bf16* mg = (bf16*)(P.ws + WS_MG) + (size_t)g * 256 * 512;
    for (int i = t; i < 256 * 512; i += nt) { const int n = i / 512, k = i % 512, tt = n / 16, c = n % 16; float v;
        if (k < 256) { const int s = k / 16, c2 = k % 16;
            if (tt > s) v = kt[((0 * 16) + (tt - s)) * 256 + c * 16 + c2];
            else if (tt < s) v = kt[((1 * 16) + (s - tt)) * 256 + c * 16 + c2];
            else v = kt[c * 16 + c2] + kt[16 * 256 + c * 16 + c2] + (c == c2 ? dv[g * 16 + c] : 0.f);
        } else { const int kk = k - 256, d = kk / 128, part = (kk / 64) & 1, p = kk % 64;
            const float2 C = cc[(d * 16 + c) * 64 + p], A = apw[(d * 64 + p) * 17 + (d == 0 ? tt + 1 : 16 - tt)];
            v = part == 0 ? (C.x * A.x - C.y * A.y) : -(C.x * A.y + C.y * A.x); }
        mg[i] = (bf16)f2bf(v); }
    bf16* wi = (bf16*)(P.ws + WS_WINS) + (size_t)g * 2 * 128 * 256;
    for (int i = t; i < 2 * 128 * 256; i += nt) { const int d = i / (128 * 256), n = (i / 256) % 128, k = i % 256, s = k / 16, c2 = k % 16, p = n % 64;
        const float2 A = apw[(d * 64 + p) * 17 + (d == 0 ? 15 - s : s)], B = bb[(d * 64 + p) * 16 + c2];
        const float v = n < 64 ? (A.x * B.x - A.y * B.y) : (A.x * B.y + A.y * B.x);
        wi[i] = (bf16)f2bf(v); }
}

__device__ __forceinline__ void norm_mod_row(const float* xrow, const float* gam, const float* sc, const float* sh, bf16* orow, int lane) {
    const f32x4* xr = (const f32x4*)xrow + lane; f32x4 v[4]; float s = 0.f;
#pragma unroll
    for (int j = 0; j < 4; ++j) { v[j] = xr[64 * j]; s += (v[j].x * v[j].x + v[j].y * v[j].y) + (v[j].z * v[j].z + v[j].w * v[j].w); }
    const float r = rsqrtf(wave_sum(s) * (1.f / D) + EPS);
    unsigned long long* o8 = (unsigned long long*)orow + lane;
#pragma unroll
    for (int j = 0; j < 4; ++j) { const f32x4 g4 = ((const f32x4*)gam)[lane + 64 * j], s4 = ((const f32x4*)sc)[lane + 64 * j], h4 = ((const f32x4*)sh)[lane + 64 * j];
        const float a = v[j].x * r * g4.x * (1.f + s4.x) + h4.x, b = v[j].y * r * g4.y * (1.f + s4.y) + h4.y, c = v[j].z * r * g4.z * (1.f + s4.z) + h4.z, d = v[j].w * r * g4.w * (1.f + s4.w) + h4.w;
        o8[64 * j] = (unsigned long long)pk2(a, b) | ((unsigned long long)pk2(c, d) << 32); }
}

template <bool PAIR, class F>
__device__ __forceinline__ void ngemm_dev(const F& f, const bf16* Bt, long ldb, long strideBz, int K, int N, int Z, int gw, int ngw, int lane) {
    const int fr = lane & 15, fq = lane >> 4;
    const int nbx = PAIR ? (N / 256) * 4 : N / 64;
    long base = 0;
    for (int z = 0; z < Z; ++z) {
        const int Mz = f.mcount(z); const int m16 = (Mz + 15) >> 4; const long nun = (long)m16 * nbx;
        const bf16* B = Bt + (size_t)f.bz(z) * strideBz;
        for (long idx = base + (((long)gw - base % ngw) + ngw) % ngw; idx < base + nun; idx += ngw) {
            const int u = (int)(idx - base), mi = u % m16, bx = u / m16;
            const int n0 = PAIR ? (bx / 4) * 256 + (bx % 4) * 32 : bx * 64;
            const int mb = mi * 16;
            int mr = mb + fr; if (mr > Mz - 1) mr = Mz - 1;
            const bf16* arow = f.arow(z, mr);
            f32x4 acc[4];
#pragma unroll
            for (int j = 0; j < 4; ++j) acc[j] = (f32x4){0.f, 0.f, 0.f, 0.f};
            for (int k0 = 0; k0 < K; k0 += 32) {
                const bf16x8 a = *(const bf16x8*)(arow + k0 + fq * 8);
#pragma unroll
                for (int j = 0; j < 4; ++j) { const int nc = n0 + (PAIR ? (j & 1) * 16 + (j >> 1) * 128 : j * 16) + fr;
                    const bf16x8 b = *(const bf16x8*)(B + (size_t)nc * ldb + k0 + fq * 8);
                    acc[j] = __builtin_amdgcn_mfma_f32_16x16x32_bf16(a, b, acc[j], 0, 0, 0); }
            }
#pragma unroll
            for (int r = 0; r < 4; ++r) { const int m = mb + fq * 4 + r; if (m >= Mz) continue;
                if (PAIR) {
#pragma unroll
                    for (int j = 0; j < 2; ++j) f.epi2(z, m, n0 + j * 16 + fr, acc[j][r], acc[2 + j][r]);
                } else {
#pragma unroll
                    for (int j = 0; j < 4; ++j) f.epi(z, m, n0 + j * 16 + fr, acc[j][r]);
                } }
        }
        base += nun;
    }
}

struct FProj {
    __device__ int bz(int z) const { return z; }
    unsigned char* ws;
    __device__ int mcount(int) const { return NTOK; }
    __device__ const bf16* arow(int, int m) const { return (const bf16*)(ws + WS_H1) + (size_t)m * D; }
    __device__ void epi(int, int m, int n, float v) const {
        if (n < 512) { const int g = n >> 4, c = n & 15, b = m / SEQ, l = m % SEQ;
            ((bf16*)(ws + WS_AG))[((size_t)g * 1024 + b * NCH + l / CT) * 512 + (l % CT) * 16 + c] = (bf16)f2bf(v); }
        else if (n < 2048) ((bf16*)(ws + WS_CBV))[(size_t)m * 1536 + (n - 512)] = (bf16)f2bf(v);
        else ((bf16*)(ws + WS_GATES))[(size_t)m * 2048 + (n - 2048)] = (bf16)f2bf(sigmoidf_(v));
    }
    __device__ void epi2(int, int, int, float, float) const {}
};
struct FProjC {
    __device__ int bz(int z) const { return z; }
    unsigned char* ws;
    __device__ int mcount(int) const { return NCTX; }
    __device__ const bf16* arow(int, int m) const { return (const bf16*)(ws + WS_H1) + (size_t)(NTOK + m) * D; }
    __device__ void epi(int, int m, int n, float v) const { const int g = n >> 4, c = n & 15, b = m / CTXL, l = m % CTXL;
        ((bf16*)(ws + WS_UC))[((size_t)g * 128 + b * NCHC + l / CT) * 256 + (l % CT) * 16 + c] = (bf16)f2bf(v); }
    __device__ void epi2(int, int, int, float, float) const {}
};
struct FSloc {
    unsigned char* ws;
    __device__ int bz(int z) const { return z >> 3; }
    __device__ int mcount(int) const { return NCHT; }
    __device__ const bf16* arow(int z, int m) const { const int b = z & 7, g = z >> 4;
        return m < NCHC ? (const bf16*)(ws + WS_UC) + ((size_t)g * 128 + b * NCHC + m) * 256 : (const bf16*)(ws + WS_AG) + ((size_t)g * 1024 + b * NCH + (m - NCHC)) * 512; }
    __device__ void epi(int z, int m, int n, float v) const { ((float*)(ws + WS_SLOC))[((size_t)z * NCHT + m) * 128 + n] = v; }
    __device__ void epi2(int, int, int, float, float) const {}
};
struct FSsmOut {
    __device__ int bz(int z) const { return z; }
    unsigned char* ws;
    __device__ int mcount(int) const { return 1024; }
    __device__ const bf16* arow(int z, int m) const { return (const bf16*)(ws + WS_AG) + ((size_t)z * 1024 + m) * 512; }
    __device__ void epi(int z, int m, int n, float v) const { const int b = m / NCH, ch = m % NCH, tt = n >> 4, c = n & 15;
        ((bf16*)(ws + WS_YG))[((size_t)b * SEQ + ch * CT + tt) * 512 + z * 16 + c] = (bf16)f2bf(gelu_tanh(v)); }
    __device__ void epi2(int, int, int, float, float) const {}
};
struct FGlu {
    __device__ int bz(int z) const { return z; }
    unsigned char* ws;
    __device__ int mcount(int) const { return NTOK; }
    __device__ const bf16* arow(int, int m) const { return (const bf16*)(ws + WS_YG) + (size_t)m * 512; }
    __device__ void epi(int, int, int, float) const {}
    __device__ void epi2(int, int m, int n, float a, float b) const { ((bf16*)(ws + WS_GLU))[(size_t)m * 512 + (n >> 8) * 128 + (n & 255)] = (bf16)f2bf(a * sigmoidf_(b)); }
};
struct FMergeA {
    __device__ int bz(int z) const { return z; }
    unsigned char* ws;
    __device__ int mcount(int) const { return NTOK; }
    __device__ const bf16* arow(int, int m) const { return (const bf16*)(ws + WS_GLU) + (size_t)m * 512; }
    __device__ void epi(int, int m, int n, float v) const { const float ga = bf2f(((const bf16*)(ws + WS_GATES))[(size_t)m * 2048 + n]);
        ((bf16*)(ws + WS_MERGED))[(size_t)m * 1024 + n] = (bf16)f2bf(ga * v); }
    __device__ void epi2(int, int, int, float, float) const {}
};
struct FMergeB {
    __device__ int bz(int z) const { return z; }
    unsigned char* ws;
    __device__ int mcount(int) const { return NTOK; }
    __device__ const bf16* arow(int, int m) const { return (const bf16*)(ws + WS_CBR) + (size_t)m * 512; }
    __device__ void epi(int, int m, int n, float v) const { const float gb = bf2f(((const bf16*)(ws + WS_GATES))[(size_t)m * 2048 + 1024 + n]);
        bf16* o = (bf16*)(ws + WS_MERGED) + (size_t)m * 1024 + n; *o = (bf16)f2bf(bf2f(*o) + gb * v); }
    __device__ void epi2(int, int, int, float, float) const {}
};
struct FWo {
    __device__ int bz(int z) const { return z; }
    unsigned char* ws; const float* x;
    __device__ int mcount(int) const { return NTOK; }
    __device__ const bf16* arow(int, int m) const { return (const bf16*)(ws + WS_MERGED) + (size_t)m * 1024; }
    __device__ void epi(int, int m, int n, float v) const { const float g1 = ((const float*)(ws + WS_MOD))[(m / SEQ) * 6144 + 2048 + n];
        ((float*)(ws + WS_XL1))[(size_t)m * D + n] = x[(size_t)m * D + n] + g1 * v; }
    __device__ void epi2(int, int, int, float, float) const {}
};
struct FRouter {
    __device__ int bz(int z) const { return z; }
    unsigned char* ws;
    __device__ int mcount(int) const { return NTOK; }
    __device__ const bf16* arow(int, int m) const { return (const bf16*)(ws + WS_H2) + (size_t)m * D; }
    __device__ void epi(int, int m, int n, float v) const { ((float*)(ws + WS_SCORES))[(size_t)m * 256 + n] = sigmoidf_(v); }
    __device__ void epi2(int, int, int, float, float) const {}
};
struct FShared {
    __device__ int bz(int z) const { return z; }
    unsigned char* ws;
    __device__ int mcount(int) const { return NTOK; }
    __device__ const bf16* arow(int, int m) const { return (const bf16*)(ws + WS_H2) + (size_t)m * D; }
    __device__ void epi(int, int, int, float) const {}
    __device__ void epi2(int, int m, int n, float a, float b) const { ((bf16*)(ws + WS_HS))[(size_t)m * 256 + (n >> 8) * 128 + (n & 255)] = (bf16)f2bf(siluf_(a) * b); }
};
struct FSharedDown {
    __device__ int bz(int z) const { return z; }
    unsigned char* ws;
    __device__ int mcount(int) const { return NTOK; }
    __device__ const bf16* arow(int, int m) const { return (const bf16*)(ws + WS_HS) + (size_t)m * 256; }
    __device__ void epi(int, int m, int n, float v) const { const float g2 = ((const float*)(ws + WS_MOD))[(m / SEQ) * 6144 + 5120 + n];
        ((float*)(ws + WS_XL1))[(size_t)m * D + n] += g2 * v; }
    __device__ void epi2(int, int, int, float, float) const {}
};
struct FMoe1 {
    __device__ int bz(int z) const { return z; }
    unsigned char* ws; const int* stp;
    __device__ int mcount(int z) const { return (int)((const unsigned*)(ws + WS_CTL))[CW_CNT + z]; }
    __device__ const bf16* arow(int z, int m) const { const int ts = ((const int*)(ws + WS_LIST))[(size_t)z * LIST_CAP + m]; return (const bf16*)(ws + WS_H2) + (size_t)(ts >> 3) * D; }
    __device__ void epi(int, int, int, float) const {}
    __device__ void epi2(int z, int m, int n, float a, float b) const { const int st = stp[z];
        ((bf16*)(ws + WS_HBUF))[(size_t)(st + m) * 256 + (n >> 8) * 128 + (n & 255)] = (bf16)f2bf(siluf_(a) * b); }
};
struct FMoe2 {
    __device__ int bz(int z) const { return z; }
    unsigned char* ws; const int* stp;
    __device__ int mcount(int z) const { return (int)((const unsigned*)(ws + WS_CTL))[CW_CNT + z]; }
    __device__ const bf16* arow(int z, int m) const { const int st = stp[z]; return (const bf16*)(ws + WS_HBUF) + (size_t)(st + m) * 256; }
    __device__ void epi(int z, int m, int n, float v) const { const int ts = ((const int*)(ws + WS_LIST))[(size_t)z * LIST_CAP + m]; const float w = ((const float*)(ws + WS_TW))[ts];
        ((bf16*)(ws + WS_YSLOT))[(size_t)ts * D + n] = (bf16)f2bf(w * v); }
    __device__ void epi2(int, int, int, float, float) const {}
};

__device__ __forceinline__ void route_token(const Ptrs& P, int tok, int lane) {
    const f32x4 sc = ((const f32x4*)((const float*)(P.ws + WS_SCORES) + (size_t)tok * 256))[lane];
    const f32x4 bi = ((const f32x4*)P.in[23])[lane];
    float c0 = sc.x + bi.x, c1 = sc.y + bi.y, c2 = sc.z + bi.z, c3 = sc.w + bi.w;
    float t1 = fmaxf(c0, c1), t2 = fminf(c0, c1);
    { const float a = fmaxf(c2, c3), b = fminf(c2, c3); const float n1 = fmaxf(t1, a); const float n2 = fmaxf(fminf(t1, a), fmaxf(t2, b)); t1 = n1; t2 = n2; }
#pragma unroll
    for (int o = 1; o < 8; o <<= 1) { const float a = __shfl_xor(t1, o), b = __shfl_xor(t2, o); const float n1 = fmaxf(t1, a); const float n2 = fmaxf(fminf(t1, a), fmaxf(t2, b)); t1 = n1; t2 = n2; }
    const float gs = t1 + t2; const int myg = lane >> 3; int rank = 0;
#pragma unroll
    for (int j = 0; j < 8; ++j) { const float o = __shfl(gs, j * 8); rank += (o > gs || (o == gs && j < myg)) ? 1 : 0; }
    if (rank >= 4) { c0 = c1 = c2 = c3 = -INFINITY; }
    int sel_e = 0; float sel_s = 0.f; float ssum = 0.f;
#pragma unroll
    for (int k = 0; k < 8; ++k) {
        float bv = c0, bs = sc.x; int be = lane * 4;
        if (c1 > bv) { bv = c1; bs = sc.y; be = lane * 4 + 1; }
        if (c2 > bv) { bv = c2; bs = sc.z; be = lane * 4 + 2; }
        if (c3 > bv) { bv = c3; bs = sc.w; be = lane * 4 + 3; }
#pragma unroll
        for (int o = 1; o < 64; o <<= 1) { const float ov = __shfl_xor(bv, o), os = __shfl_xor(bs, o); const int oe = __shfl_xor(be, o);
            if (ov > bv || (ov == bv && oe < be)) { bv = ov; bs = os; be = oe; } }
        if (lane == k) { sel_e = be; sel_s = bs; }
        ssum += bs;
        if ((be >> 2) == lane) { const int q = be & 3; if (q == 0) c0 = -INFINITY; else if (q == 1) c1 = -INFINITY; else if (q == 2) c2 = -INFINITY; else c3 = -INFINITY; }
    }
    if (lane < 8) {
        const float w = sel_s / ssum * 2.5f;
        unsigned* cnt = (unsigned*)(P.ws + WS_CTL) + CW_CNT;
        const unsigned rk = atomicAdd(&cnt[sel_e], 1u);
        ((int*)(P.ws + WS_LIST))[(size_t)sel_e * LIST_CAP + rk] = tok * 8 + lane;
        ((float*)(P.ws + WS_TW))[tok * 8 + lane] = w;
    }
}
#define XB_TMO      128
#define XB_XCNT(j)  (256  + 64 * (j))
#define XB_XSUB(j)  (1280 + 64 * (j))
#define XB_XGEN(j)  (2304 + 64 * (j))
#define XB_TOP      3328
#define XB_TOPGEN   3392
#define XCD_BAR_WORDS 3456
#define XB_SPIN_CAP (1u << 18)
#define LAS __attribute__((address_space(3)))

__device__ __forceinline__ unsigned xb_ld(unsigned* p)              { return __hip_atomic_load(p, __ATOMIC_RELAXED, __HIP_MEMORY_SCOPE_AGENT); }
__device__ __forceinline__ unsigned xb_add(unsigned* p, unsigned v) { return __hip_atomic_fetch_add(p, v, __ATOMIC_RELAXED, __HIP_MEMORY_SCOPE_AGENT); }
__device__ __forceinline__ unsigned xb_xcc_id() { return (unsigned)__builtin_amdgcn_s_getreg((3 << 11) | 20) & 0xFu; }
#define XB_SPIN(cond, bar) do { unsigned _sp = 0; while (cond) { __builtin_amdgcn_s_sleep(1); \
    if ((++_sp & 255u) == 0u) { if (xb_ld(&(bar)[XB_TMO])) break; if (_sp > XB_SPIN_CAP) { atomicAdd(&(bar)[XB_TMO], 1u); break; } } } } while (0)

struct XcdBarrier {
    unsigned* bar; unsigned x;
    volatile LAS unsigned* st;
};

__device__ __forceinline__ XcdBarrier xcd_barrier_post(unsigned* bar, volatile LAS unsigned* st) {
    XcdBarrier b; b.bar = bar; b.x = xb_xcc_id(); b.st = st;
    if (threadIdx.x == 0) (void)xb_add(&bar[XB_XCNT(b.x)], 1u);
    return b;
}
__device__ __forceinline__ void xcd_barrier_complete(unsigned* bar, unsigned x, unsigned& nloc, unsigned& nx) {
    const unsigned G = gridDim.x * gridDim.y * gridDim.z;
    unsigned sum, cnt, mine, sp = 0u;
    for (;;) {
        sum = 0u; cnt = 0u; mine = 0u;
#pragma unroll
        for (unsigned j = 0; j < 16; ++j) { const unsigned c = xb_ld(&bar[XB_XCNT(j)]); sum += c; cnt += (c > 0u) ? 1u : 0u; mine = (j == x) ? c : mine; }
        if (sum == G) break;
        __builtin_amdgcn_s_sleep(1);
        if ((++sp & 255u) == 0u) { if (xb_ld(&bar[XB_TMO])) break; if (sp > XB_SPIN_CAP) { atomicAdd(&bar[XB_TMO], 1u); break; } }
    }
    nloc = mine > 0u ? mine : 1u; nx = cnt > 0u ? cnt : 1u;
}

__device__ __forceinline__ void xcd_barrier(const XcdBarrier& b) {
    asm volatile("s_waitcnt vmcnt(0)" ::: "memory");
    __syncthreads();
    if (threadIdx.x == 0) {
        unsigned* bar = b.bar;
        __builtin_amdgcn_s_waitcnt(0);
        unsigned nloc = b.st[0], nx = b.st[1];
        if (nloc == 0u) { xcd_barrier_complete(bar, b.x, nloc, nx); b.st[0] = nloc; b.st[1] = nx; }
        const unsigned old = xb_add(&bar[XB_XSUB(b.x)], 1u);
        const unsigned gen = old / nloc;
        if (old + 1u == (gen + 1u) * nloc) {
            __builtin_amdgcn_fence(__ATOMIC_RELEASE, "agent");
            asm volatile("s_waitcnt vmcnt(0)" ::: "memory");
            const unsigned og = xb_add(&bar[XB_TOP], 1u);
            const unsigned tg = og / nx;
            if (og + 1u == (tg + 1u) * nx) xb_add(&bar[XB_TOPGEN], 1u);
            else XB_SPIN(xb_ld(&bar[XB_TOPGEN]) == tg, bar);
            __builtin_amdgcn_fence(__ATOMIC_ACQUIRE, "agent");
            xb_add(&bar[XB_XGEN(b.x)], 1u);
            asm volatile("s_waitcnt vmcnt(0)" ::: "memory");
        } else {
            XB_SPIN(xb_ld(&bar[XB_XGEN(b.x)]) == gen, bar);
            __builtin_amdgcn_fence(__ATOMIC_ACQUIRE, "agent");
            asm volatile("s_waitcnt vmcnt(0)" ::: "memory");
        }
    }
    __syncthreads();
}

constexpr int NWAVES = 8, NTHREADS = NWAVES * 64;
constexpr int RING_BYTES = 131072, LDSCTL_OFF = RING_BYTES, LDS_BYTES = 147456;
constexpr int CW_BAR = 4096;
static_assert((CW_BAR + XCD_BAR_WORDS) * 4 <= (int)MiB, "control words inside the memset region");
static_assert(SSM_LDS_BYTES <= RING_BYTES && (9 * 1024 + 21 * 24 * 9) * 4 <= RING_BYTES && NWAVES * 64 * 33 * 4 <= RING_BYTES, "LDS scratch fits the ring region");

__global__ void __launch_bounds__(NTHREADS, 2) mega(Ptrs P) {
    extern __shared__ __attribute__((aligned(16))) unsigned char lds[];
    const int tid = threadIdx.x, lane = tid & 63, wave = __builtin_amdgcn_readfirstlane(tid >> 6);
    const int G = gridDim.x; const int bx = blockIdx.x; const int vcu = (G % 8 == 0) ? (bx % 8) * (G / 8) + bx / 8 : bx;
    const int gw = vcu * NWAVES + wave, NGW = G * NWAVES;
    unsigned char* ws = P.ws;
    for (int u = tid; u < (LDS_BYTES - LDSCTL_OFF) / 4; u += NTHREADS) ((unsigned*)(lds + LDSCTL_OFF))[u] = 0u;
    __syncthreads();
    XcdBarrier bar = xcd_barrier_post((unsigned*)(ws + WS_CTL) + CW_BAR, (volatile LAS unsigned*)(lds + LDSCTL_OFF));
#define GRID_BAR() xcd_barrier(bar)
    const float* mod = (const float*)(ws + WS_MOD);

    for (int g = vcu; g < SG; g += G) ssm_tables_item(P, g, lds, tid, NTHREADS);
    for (int cb = vcu; cb < 256; cb += G) mod_cols(P, cb, (float*)lds, tid, NTHREADS);
    __syncthreads();
    for (int it = gw; it < IT_ALL; it += NGW) wprep_item(P, it, (float*)lds + wave * (64 * 33), lane);
    GRID_BAR();
    for (int r = gw; r < NROW; r += NGW) {
        const bool lat = r < NTOK; const int mr = lat ? r / SEQ : 8;
        const float* xrow = lat ? P.in[0] + (size_t)r * D : P.in[2] + (size_t)(r - NTOK) * D;
        norm_mod_row(xrow, P.in[6], mod + mr * 6144 + 1024, mod + mr * 6144 + 0, (bf16*)(ws + WS_H1) + (size_t)r * D, lane);
    }
    GRID_BAR();
    ngemm_dev<false>(FProj{ws}, (const bf16*)(ws + WS_WIN_T), D, 0, D, INC, 1, gw, NGW, lane);
    ngemm_dev<false>(FProjC{ws}, (const bf16*)(ws + WS_WIN_T), D, 0, D, 512, 1, gw, NGW, lane);
    GRID_BAR();
    {
        const bf16* cbv = (const bf16*)(ws + WS_CBV); bf16* cbr = (bf16*)(ws + WS_CBR); const float* cw = P.in[19];
        const size_t total = (size_t)NTOK * 512;
        for (size_t i = (size_t)vcu * NTHREADS + tid; i < total; i += (size_t)G * NTHREADS) {
            const int tok = (int)(i / 512), j = (int)(i % 512), col = tok & 63;
            const bf16* r = cbv + (size_t)tok * 1536;
            float acc = cw[512 + j] * bf2f(r[512 + j]) * bf2f(r[1024 + j]);
            if (col > 0) acc += cw[j] * bf2f(r[512 + j - 1536]) * bf2f(r[1024 + j - 1536]);
            if (col < 63) acc += cw[1024 + j] * bf2f(r[512 + j + 1536]) * bf2f(r[1024 + j + 1536]);
            cbr[i] = (bf16)f2bf(bf2f(r[j]) * acc);
        }
        ngemm_dev<false>(FSloc{ws}, (const bf16*)(ws + WS_WINS), 256, (long)128 * 256, 256, 128, SG * 2 * NB, gw, NGW, lane);
    }
    GRID_BAR();
    for (int it = gw; it < SG * 2 * NB; it += NGW) {
        const int p = lane, b = it % 8, d = (it / 8) % 2, g = it / 16;
        const float* a16 = (const float*)(ws + WS_A16); const float ar = a16[((g * 2 + d) * 64 + p) * 2], ai = a16[((g * 2 + d) * 64 + p) * 2 + 1];
        const float* sl = (const float*)(ws + WS_SLOC) + (size_t)((g * 2 + d) * 8 + b) * NCHT * 128;
        bf16* ag = (bf16*)(ws + WS_AG) + ((size_t)g * 1024 + b * NCH) * 512 + 256 + d * 128;
        float sr = 0.f, si = 0.f;
        for (int kk = 0; kk < NCHC; ++kk) { const int k = d == 0 ? kk : NCHC - 1 - kk; const float lr = sl[k * 128 + p], li = sl[k * 128 + 64 + p];
            const float nr = ar * sr - ai * si + lr, ni = ar * si + ai * sr + li; sr = nr; si = ni; }
        for (int kk = 0; kk < NCH; ++kk) { const int k = d == 0 ? kk : NCH - 1 - kk;
            ag[(size_t)k * 512 + p] = (bf16)f2bf(sr); ag[(size_t)k * 512 + 64 + p] = (bf16)f2bf(si);
            const float lr = sl[(NCHC + k) * 128 + p], li = sl[(NCHC + k) * 128 + 64 + p];
            const float nr = ar * sr - ai * si + lr, ni = ar * si + ai * sr + li; sr = nr; si = ni; }
    }
    GRID_BAR();
    ngemm_dev<false>(FSsmOut{ws}, (const bf16*)(ws + WS_MG), 512, (long)256 * 512, 512, 256, SG, gw, NGW, lane);
    GRID_BAR();
    ngemm_dev<true>(FGlu{ws}, (const bf16*)(ws + WS_WGLU_T), 512, 0, 512, 1024, 1, gw, NGW, lane);
    GRID_BAR();
    ngemm_dev<false>(FMergeA{ws}, (const bf16*)(ws + WS_WSSM_T), 512, 0, 512, 1024, 1, gw, NGW, lane);
    GRID_BAR();
    ngemm_dev<false>(FMergeB{ws}, (const bf16*)(ws + WS_WCONV_T), 512, 0, 512, 1024, 1, gw, NGW, lane);
    GRID_BAR();
    ngemm_dev<false>(FWo{ws, P.in[0]}, (const bf16*)(ws + WS_WO_T), 1024, 0, 1024, 1024, 1, gw, NGW, lane);
    GRID_BAR();
    for (int r = gw; r < NTOK; r += NGW) { const int b = r / SEQ;
        norm_mod_row((const float*)(ws + WS_XL1) + (size_t)r * D, P.in[7], mod + b * 6144 + 4096, mod + b * 6144 + 3072, (bf16*)(ws + WS_H2) + (size_t)r * D, lane); }
    GRID_BAR();
    ngemm_dev<false>(FRouter{ws}, (const bf16*)(ws + WS_WRS_T), 1024, 0, 1024, 256, 1, gw, NGW, lane);
    ngemm_dev<true>(FShared{ws}, (const bf16*)(ws + WS_WRS_T) + (size_t)256 * 1024, 1024, 0, 1024, 512, 1, gw, NGW, lane);
    GRID_BAR();
    for (int tok = gw; tok < NTOK; tok += NGW) route_token(P, tok, lane);
    ngemm_dev<false>(FSharedDown{ws}, (const bf16*)(ws + WS_WSD_T), 256, 0, 256, 1024, 1, gw, NGW, lane);
    GRID_BAR();
    int* stp = (int*)(ws + WS_START) + (size_t)bx * 260;
    if (wave == 0) {
        const unsigned* cnt = (const unsigned*)(ws + WS_CTL) + CW_CNT;
        int c4[4], s = 0;
#pragma unroll
        for (int i = 0; i < 4; ++i) { c4[i] = ((int)__hip_atomic_load(&cnt[lane * 4 + i], __ATOMIC_RELAXED, __HIP_MEMORY_SCOPE_AGENT) + 255) & ~255; s += c4[i]; }
        int incl = s;
#pragma unroll
        for (int o = 1; o < 64; o <<= 1) { const int v = __shfl_up(incl, o); if (lane >= o) incl += v; }
        int ex = incl - s;
#pragma unroll
        for (int i = 0; i < 4; ++i) { stp[lane * 4 + i] = ex; ex += c4[i]; }
    }
    asm volatile("s_waitcnt vmcnt(0)" ::: "memory");
    __syncthreads();
    ngemm_dev<true>(FMoe1{ws, stp}, (const bf16*)(ws + WS_WGU_T), 1024, (long)512 * 1024, 1024, 512, NE, gw, NGW, lane);
    GRID_BAR();
    ngemm_dev<false>(FMoe2{ws, stp}, (const bf16*)(ws + WS_WD_T), 256, (long)1024 * 256, 256, 1024, NE, gw, NGW, lane);
    GRID_BAR();
    for (int r = gw; r < NTOK; r += NGW) { const int b = r / SEQ;
        const f32x4* xr = (const f32x4*)((const float*)(ws + WS_XL1) + (size_t)r * D) + lane; f32x4 v[4]; float s = 0.f;
#pragma unroll
        for (int j = 0; j < 4; ++j) { f32x4 acc = (f32x4){0.f, 0.f, 0.f, 0.f};
            for (int k = 0; k < 8; ++k) { const u32x2 y = ((const u32x2*)((const bf16*)(ws + WS_YSLOT) + (size_t)(r * 8 + k) * D))[lane + 64 * j];
                acc.x += bf2f(y.x); acc.y += bf2f(y.x >> 16); acc.z += bf2f(y.y); acc.w += bf2f(y.y >> 16); }
            const f32x4 g2 = ((const f32x4*)(mod + b * 6144 + 5120))[lane + 64 * j];
            v[j] = xr[64 * j] + g2 * acc; s += (v[j].x * v[j].x + v[j].y * v[j].y) + (v[j].z * v[j].z + v[j].w * v[j].w); }
        const float rr = rsqrtf(wave_sum(s) * (1.f / D) + EPS);
        f32x4* o = (f32x4*)(P.out + (size_t)r * D) + lane;
#pragma unroll
        for (int j = 0; j < 4; ++j) { const f32x4 fg = ((const f32x4*)P.in[30])[lane + 64 * j]; o[64 * j] = v[j] * rr * fg; }
    }
#undef GRID_BAR
}

extern "C" void kernel_launch(void* const* d_in, const int* in_sizes, int n_in, void* d_out, int out_size, void* d_ws, size_t ws_size, hipStream_t stream) {
    static int grid = 0;
    if (grid == 0) {
        if (n_in != 31 || out_size != NTOK * D || ws_size < WS_END) { fprintf(stderr, "kernel_launch: unexpected problem (n_in %d, out %d, ws %zu)\n", n_in, out_size, ws_size); grid = -1; return; }
        int dev = 0, cus = 0, per_cu = 0;
        if (hipGetDevice(&dev) != hipSuccess || hipDeviceGetAttribute(&cus, hipDeviceAttributeMultiprocessorCount, dev) != hipSuccess) { grid = -1; return; }
        if (hipFuncSetAttribute((const void*)mega, hipFuncAttributeMaxDynamicSharedMemorySize, LDS_BYTES) != hipSuccess) { fprintf(stderr, "kernel_launch: hipFuncSetAttribute failed\n"); grid = -1; return; }
        if (hipOccupancyMaxActiveBlocksPerMultiprocessor(&per_cu, (const void*)mega, NTHREADS, LDS_BYTES) != hipSuccess || per_cu < 1) { fprintf(stderr, "kernel_launch: occupancy query says %d blocks per CU\n", per_cu); (void)hipGetLastError(); grid = -1; return; }
        grid = cus;
    }
    if (grid < 0) return;
    Ptrs P{};
    for (int i = 0; i < 31; ++i) P.in[i] = (const float*)d_in[i];
    P.out = (float*)d_out; P.ws = (unsigned char*)d_ws;
    (void)hipMemsetAsync((char*)d_ws + WS_CTL, 0, MiB, stream);
    hipLaunchKernelGGL(mega, dim3(grid), dim3(NTHREADS), LDS_BYTES, stream, P);
}
```

```cpp
#include <hip/hip_runtime.h>
#include <cstdio>
#include <cstdint>

typedef unsigned short bf16;
typedef short bf16x8 __attribute__((ext_vector_type(8)));
typedef float f32x4 __attribute__((ext_vector_type(4)));
typedef unsigned u32x4 __attribute__((ext_vector_type(4)));
typedef unsigned u32x2 __attribute__((ext_vector_type(2)));

constexpr int D = 1024, NB = 8, SEQ = 2048, CTXL = 256;
constexpr int NTOK = NB * SEQ, NCTX = NB * CTXL, NROW = NTOK + NCTX;
constexpr int INC = 4096, SG = 32, SP = 64, SQ = 16, CT = 16;
constexpr int NCH = SEQ / CT, NCHC = CTXL / CT, NCHT = NCH + NCHC;
constexpr int NE = 256, TOPK = 8, ED = 256;
constexpr float EPS = 1e-6f;
constexpr int KSPLIT = 16;
constexpr int LIST_CAP = NTOK;
constexpr int HB_ROWS = NTOK * TOPK + NE * 256;

constexpr size_t MiB = 1u << 20;
constexpr size_t WS_CTL = 0;
constexpr size_t WS_MODP = 1 * MiB;
constexpr size_t WS_MOD = 5 * MiB;
constexpr size_t WS_A16 = 5 * MiB + 512 * 1024;
constexpr size_t WS_START = 5 * MiB + 600 * 1024;
constexpr size_t WS_WIN_T = 6 * MiB;
constexpr size_t WS_WGLU_T = 14 * MiB;
constexpr size_t WS_WSSM_T = 15 * MiB;
constexpr size_t WS_WCONV_T = 16 * MiB;
constexpr size_t WS_WO_T = 17 * MiB;
constexpr size_t WS_WRS_T = 19 * MiB;
constexpr size_t WS_WSD_T = 21 * MiB;
constexpr size_t WS_MG = 22 * MiB;
constexpr size_t WS_WINS = 30 * MiB;
constexpr size_t WS_WGU_T = 34 * MiB;
constexpr size_t WS_WD_T = 290 * MiB;
constexpr size_t WS_H1 = 418 * MiB;
constexpr size_t WS_AG = 454 * MiB;
constexpr size_t WS_UC = 486 * MiB;
constexpr size_t WS_SLOC = 488 * MiB;
constexpr size_t WS_CBV = 524 * MiB;
constexpr size_t WS_GATES = 572 * MiB;
constexpr size_t WS_CBR = 636 * MiB;
constexpr size_t WS_YG = 652 * MiB;
constexpr size_t WS_GLU = 668 * MiB;
constexpr size_t WS_MERGED = 684 * MiB;
constexpr size_t WS_YSLOT = 418 * MiB;
constexpr size_t WS_XL1 = 716 * MiB;
constexpr size_t WS_H2 = 780 * MiB;
constexpr size_t WS_SCORES = 812 * MiB;
constexpr size_t WS_HS = 828 * MiB;
constexpr size_t WS_TW = 836 * MiB;
constexpr size_t WS_LIST = 838 * MiB;
constexpr size_t WS_HBUF = 854 * MiB;
constexpr size_t WS_END = 950 * MiB;
constexpr int CW_CNT = 0;

__device__ __forceinline__ unsigned f2bf(float f) { unsigned u = __builtin_bit_cast(unsigned, f); return (u + 0x7fffu + ((u >> 16) & 1u)) >> 16; }
__device__ __forceinline__ unsigned pk2(float lo, float hi) { return f2bf(lo) | (f2bf(hi) << 16); }
__device__ __forceinline__ float bf2f(unsigned h) { return __builtin_bit_cast(float, (h & 0xffffu) << 16); }
__device__ __forceinline__ float sigmoidf_(float v) { return 1.0f / (1.0f + __expf(-v)); }
__device__ __forceinline__ float siluf_(float v) { return v / (1.0f + __expf(-v)); }
__device__ __forceinline__ float gelu_tanh(float v) { const float u = 0.7978845608028654f * (v + 0.044715f * v * v * v); return 0.5f * v * (1.0f + tanhf(u)); }
__device__ __forceinline__ float wave_sum(float v) {
#pragma unroll
    for (int o = 1; o < 64; o <<= 1) v += __shfl_xor(v, o);
    return v;
}

struct Ptrs {
    const float* in[31];
    float* out;
    unsigned char* ws;
};

__device__ __forceinline__ void mod_cols(const Ptrs& P, int cb, float* sil, int t, int nt) {
    float* part = sil + 9 * 1024;
    const float* c = P.in[1]; const float* cc = P.in[3]; const float* wm = P.in[4]; const float* bm = P.in[5];
    __syncthreads();
    for (int i = t; i < 9 * 1024; i += nt) { const int r = i >> 10, k = i & 1023; const float v = r < 8 ? c[r * D + k] : cc[k]; sil[i] = siluf_(v); }
    __syncthreads();
    if (t < 504) { const int col = t % 24, ks = t / 24; const int k0 = ks * 49, k1 = (k0 + 49 < 1024) ? k0 + 49 : 1024;
        float acc[9];
#pragma unroll
        for (int r = 0; r < 9; ++r) acc[r] = 0.f;
        for (int k = k0; k < k1; ++k) { const float w = wm[(size_t)k * 6144 + cb * 24 + col];
#pragma unroll
            for (int r = 0; r < 9; ++r) acc[r] += sil[r * 1024 + k] * w; }
#pragma unroll
        for (int r = 0; r < 9; ++r) part[(ks * 24 + col) * 9 + r] = acc[r]; }
    __syncthreads();
    if (t < 216) { const int r = t / 24, col = t % 24; float s = bm[cb * 24 + col];
        for (int ks = 0; ks < 21; ++ks) s += part[(ks * 24 + col) * 9 + r];
        ((float*)(P.ws + WS_MOD))[r * 6144 + cb * 24 + col] = s; }
    __syncthreads();
}

__device__ __forceinline__ void transpose_item(const float* W, int ldw, bf16* WT, int ldt, int k0, int n0, int dst_row0, float* scr, int lane) {
#pragma unroll 8
    for (int i = 0; i < 32; ++i) { const int kk = 2 * i + (lane >> 5); scr[kk * 33 + (lane & 31)] = W[(size_t)(k0 + kk) * ldw + n0 + (lane & 31)]; }
    asm volatile("s_waitcnt lgkmcnt(0)" ::: "memory");
    const int c = lane & 7;
#pragma unroll
    for (int j = 0; j < 4; ++j) { const int n = (lane >> 3) + 8 * j; const float* s = scr + (8 * c) * 33 + n;
        u32x4 o; o.x = pk2(s[0 * 33], s[1 * 33]); o.y = pk2(s[2 * 33], s[3 * 33]); o.z = pk2(s[4 * 33], s[5 * 33]); o.w = pk2(s[6 * 33], s[7 * 33]);
        *(u32x4*)(WT + (size_t)(dst_row0 + n) * ldt + k0 + 8 * c) = o; }
    asm volatile("s_waitcnt lgkmcnt(0)" ::: "memory");
}
constexpr int IT_WIN = 16 * 128, IT_GLU = 8 * 32, IT_SSM = 8 * 32, IT_CONV = 8 * 32, IT_WO = 16 * 32, IT_RT = 16 * 8, IT_SG = 16 * 8, IT_SU = 16 * 8, IT_SD = 4 * 32;
constexpr int IT_DENSE = IT_WIN + IT_GLU + IT_SSM + IT_CONV + IT_WO + IT_RT + IT_SG + IT_SU + IT_SD;
constexpr int IT_EG = 16 * 8, IT_ED = 4 * 32;
constexpr int IT_EXP = NE * (2 * IT_EG + IT_ED);
constexpr int IT_ALL = IT_DENSE + IT_EXP;
__device__ __forceinline__ void wprep_item(const Ptrs& P, int it, float* scr, int lane) {
    unsigned char* ws = P.ws;
    int r = it;
    if (r < IT_WIN) { const int nb = r % 128, kb = r / 128; transpose_item(P.in[8], INC, (bf16*)(ws + WS_WIN_T), D, kb * 64, nb * 32, nb * 32, scr, lane); return; } r -= IT_WIN;
    if (r < IT_GLU) { const int nb = r % 32, kb = r / 32, n0 = nb * 32; const int h = n0 / 512, j0 = n0 % 512;
        transpose_item(P.in[17], 1024, (bf16*)(ws + WS_WGLU_T), 512, kb * 64, n0, 256 * (j0 / 128) + h * 128 + (j0 % 128), scr, lane); return; } r -= IT_GLU;
    if (r < IT_SSM) { const int nb = r % 32, kb = r / 32; transpose_item(P.in[18], 1024, (bf16*)(ws + WS_WSSM_T), 512, kb * 64, nb * 32, nb * 32, scr, lane); return; } r -= IT_SSM;
    if (r < IT_CONV) { const int nb = r % 32, kb = r / 32; transpose_item(P.in[20], 1024, (bf16*)(ws + WS_WCONV_T), 512, kb * 64, nb * 32, nb * 32, scr, lane); return; } r -= IT_CONV;
    if (r < IT_WO) { const int nb = r % 32, kb = r / 32; transpose_item(P.in[21], 1024, (bf16*)(ws + WS_WO_T), 1024, kb * 64, nb * 32, nb * 32, scr, lane); return; } r -= IT_WO;
    if (r < IT_RT) { const int nb = r % 8, kb = r / 8; transpose_item(P.in[22], 256, (bf16*)(ws + WS_WRS_T), 1024, kb * 64, nb * 32, nb * 32, scr, lane); return; } r -= IT_RT;
    if (r < IT_SG) { const int nb = r % 8, kb = r / 8, j0 = nb * 32; transpose_item(P.in[27], 256, (bf16*)(ws + WS_WRS_T), 1024, kb * 64, j0, 256 + 256 * (j0 / 128) + (j0 % 128), scr, lane); return; } r -= IT_SG;
    if (r < IT_SU) { const int nb = r % 8, kb = r / 8, j0 = nb * 32; transpose_item(P.in[28], 256, (bf16*)(ws + WS_WRS_T), 1024, kb * 64, j0, 256 + 256 * (j0 / 128) + 128 + (j0 % 128), scr, lane); return; } r -= IT_SU;
    if (r < IT_SD) { const int nb = r % 32, kb = r / 32; transpose_item(P.in[29], 1024, (bf16*)(ws + WS_WSD_T), 256, kb * 64, nb * 32, nb * 32, scr, lane); return; } r -= IT_SD;
    const int e = r / (2 * IT_EG + IT_ED); r %= (2 * IT_EG + IT_ED);
    if (r < IT_EG) { const int nb = r % 8, kb = r / 8, j0 = nb * 32;
        transpose_item(P.in[24] + (size_t)e * 1024 * 256, 256, (bf16*)(ws + WS_WGU_T) + (size_t)e * 512 * 1024, 1024, kb * 64, j0, 256 * (j0 / 128) + (j0 % 128), scr, lane); return; } r -= IT_EG;
    if (r < IT_EG) { const int nb = r % 8, kb = r / 8, j0 = nb * 32;
        transpose_item(P.in[25] + (size_t)e * 1024 * 256, 256, (bf16*)(ws + WS_WGU_T) + (size_t)e * 512 * 1024, 1024, kb * 64, j0, 256 * (j0 / 128) + 128 + (j0 % 128), scr, lane); return; } r -= IT_EG;
    { const int nb = r % 32, kb = r / 32; transpose_item(P.in[26] + (size_t)e * 256 * 1024, 1024, (bf16*)(ws + WS_WD_T) + (size_t)e * 1024 * 256, 256, kb * 64, nb * 32, nb * 32, scr, lane); }
}

constexpr int SSM_LDS_BYTES = 2 * 64 * 17 * 8 + 2 * 64 * 16 * 8 + 2 * 16 * 64 * 8 + 2 * 16 * 256 * 4;
__device__ __forceinline__ void ssm_tables_item(const Ptrs& P, int g, unsigned char* lds, int t, int nt) {
    float2* apw = (float2*)lds; float2* bb = apw + 2 * 64 * 17; float2* cc = bb + 2 * 64 * 16; float* kt = (float*)(cc + 2 * 16 * 64);
    const float *lre = P.in[9], *lim = P.in[10], *ldt = P.in[11], *bre = P.in[12], *bim = P.in[13], *cre = P.in[14], *cim = P.in[15], *dv = P.in[16];
    __syncthreads();
    for (int i = t; i < 2 * 64; i += nt) { const int d = i / 64, p = i % 64;
        const double dt = exp((double)ldt[d * SG + g]); const double lr = lre[(d * SG + g) * SP + p], li = lim[(d * SG + g) * SP + p];
        for (int n = 0; n <= 16; ++n) { const double mag = exp(lr * dt * n); double ang = li * dt * n; ang -= 6.283185307179586476925 * rint(ang / 6.283185307179586476925);
            apw[(d * 64 + p) * 17 + n] = make_float2((float)(mag * (double)cosf((float)ang)), (float)(mag * (double)sinf((float)ang))); }
        const double ar = (double)apw[(d * 64 + p) * 17 + 1].x, ai = (double)apw[(d * 64 + p) * 17 + 1].y;
        const double den = lr * lr + li * li; const double kr = ((ar - 1.0) * lr + ai * li) / den, ki = (ai * lr - (ar - 1.0) * li) / den;
        for (int c = 0; c < 16; ++c) { const double br = bre[((d * SG + g) * SP + p) * SQ + c], bi = bim[((d * SG + g) * SP + p) * SQ + c];
            bb[(d * 64 + p) * 16 + c] = make_float2((float)(kr * br - ki * bi), (float)(kr * bi + ki * br)); }
        float* a16 = (float*)(P.ws + WS_A16); a16[((g * 2 + d) * 64 + p) * 2 + 0] = apw[(d * 64 + p) * 17 + 16].x; a16[((g * 2 + d) * 64 + p) * 2 + 1] = apw[(d * 64 + p) * 17 + 16].y;
    }
    for (int i = t; i < 2 * 16 * 64; i += nt) { const int d = i / 1024, c = (i / 64) % 16, p = i % 64;
        cc[i] = make_float2(cre[((d * SG + g) * SQ + c) * SP + p], cim[((d * SG + g) * SQ + c) * SP + p]); }
    __syncthreads();
    for (int i = t; i < 2 * 16 * 256; i += nt) { const int d = i / 4096, tau = (i / 256) % 16, c = (i / 16) % 16, c2 = i % 16; float s = 0.f;
        for (int p = 0; p < 64; ++p) { const float2 C = cc[(d * 16 + c) * 64 + p], A = apw[(d * 64 + p) * 17 + tau], B = bb[(d * 64 + p) * 16 + c2];
            const float abr = A.x * B.x - A.y * B.y, abi = A.x * B.y + A.y * B.x; s += C.x * abr - C.y * abi; }
        kt[i] = s; }
    __syncthreads();
    bf16* mg = (bf16*)(P.ws + WS_MG) + (size_t)g * 256 * 512;
    for (int i = t; i < 256 * 512; i += nt) { const int n = i / 512, k = i % 512, tt = n / 16, c = n % 16; float v;
        if (k < 256) { const int s = k / 16, c2 = k % 16;
            if (tt > s) v = kt[((0 * 16) + (tt - s)) * 256 + c * 16 + c2];
            else if (tt < s) v = kt[((1 * 16) + (s - tt)) * 256 + c * 16 + c2];
            else v = kt[c * 16 + c2] + kt[16 * 256 + c * 16 + c2] + (c == c2 ? dv[g * 16 + c] : 0.f);
        } else { const int kk = k - 256, d = kk / 128, part = (kk / 64) & 1, p = kk % 64;
            const float2 C = cc[(d * 16 + c) * 64 + p], A = apw[(d * 64 + p) * 17 + (d == 0 ? tt + 1 : 16 - tt)];
            v = part == 0 ? (C.x * A.x - C.y * A.y) : -(C.x * A.y + C.y * A.x); }
        mg[i] = (bf16)f2bf(v); }
    bf16* wi = (bf16*)(P.ws + WS_WINS) + (size_t)g * 2 * 128 * 256;
    for (int i = t; i < 2 * 128 * 256; i += nt) { const int d = i / (128 * 256), n = (i / 256) % 128, k = i % 256, s = k / 16, c2 = k % 16, p = n % 64;
        const float2 A = apw[(d * 64 + p) * 17 + (d == 0 ? 15 - s : s)], B = bb[(d * 64 + p) * 16 + c2];
        const float v = n < 64 ? (A.x * B.x - A.y * B.y) : (A.x * B.y + A.y * B.x);
        wi[i] = (bf16)f2bf(v); }
}

__device__ __forceinline__ void norm_mod_row(const float* xrow, const float* gam, const float* sc, const float* sh, bf16* orow, int lane) {
    const f32x4* xr = (const f32x4*)xrow + lane; f32x4 v[4]; float s = 0.f;
#pragma unroll
    for (int j = 0; j < 4; ++j) { v[j] = xr[64 * j]; s += (v[j].x * v[j].x + v[j].y * v[j].y) + (v[j].z * v[j].z + v[j].w * v[j].w); }
    const float r = rsqrtf(wave_sum(s) * (1.f / D) + EPS);
    unsigned long long* o8 = (unsigned long long*)orow + lane;
#pragma unroll
    for (int j = 0; j < 4; ++j) { const f32x4 g4 = ((const f32x4*)gam)[lane + 64 * j], s4 = ((const f32x4*)sc)[lane + 64 * j], h4 = ((const f32x4*)sh)[lane + 64 * j];
        const float a = v[j].x * r * g4.x * (1.f + s4.x) + h4.x, b = v[j].y * r * g4.y * (1.f + s4.y) + h4.y, c = v[j].z * r * g4.z * (1.f + s4.z) + h4.z, d = v[j].w * r * g4.w * (1.f + s4.w) + h4.w;
        o8[64 * j] = (unsigned long long)pk2(a, b) | ((unsigned long long)pk2(c, d) << 32); }
}

template <bool PAIR, class F>
__device__ __forceinline__ void ngemm_dev(const F& f, const bf16* Bt, long ldb, long strideBz, int K, int N, int Z, int gw, int ngw, int lane) {
    const int fr = lane & 15, fq = lane >> 4;
    const int nbx = PAIR ? (N / 256) * 4 : N / 64;
    long base = 0;
    for (int z = 0; z < Z; ++z) {
        const int Mz = f.mcount(z); const int m16 = (Mz + 15) >> 4; const long nun = (long)m16 * nbx;
        const bf16* B = Bt + (size_t)f.bz(z) * strideBz;
        for (long idx = base + (((long)gw - base % ngw) + ngw) % ngw; idx < base + nun; idx += ngw) {
            const int u = (int)(idx - base), mi = u % m16, bx = u / m16;
            const int n0 = PAIR ? (bx / 4) * 256 + (bx % 4) * 32 : bx * 64;
            const int mb = mi * 16;
            int mr = mb + fr; if (mr > Mz - 1) mr = Mz - 1;
            const bf16* arow = f.arow(z, mr);
            f32x4 acc[4];
#pragma unroll
            for (int j = 0; j < 4; ++j) acc[j] = (f32x4){0.f, 0.f, 0.f, 0.f};
            for (int k0 = 0; k0 < K; k0 += 32) {
                const bf16x8 a = *(const bf16x8*)(arow + k0 + fq * 8);
#pragma unroll
                for (int j = 0; j < 4; ++j) { const int nc = n0 + (PAIR ? (j & 1) * 16 + (j >> 1) * 128 : j * 16) + fr;
                    const bf16x8 b = *(const bf16x8*)(B + (size_t)nc * ldb + k0 + fq * 8);
                    acc[j] = __builtin_amdgcn_mfma_f32_16x16x32_bf16(a, b, acc[j], 0, 0, 0); }
            }
#pragma unroll
            for (int r = 0; r < 4; ++r) { const int m = mb + fq * 4 + r; if (m >= Mz) continue;
                if (PAIR) {
#pragma unroll
                    for (int j = 0; j < 2; ++j) f.epi2(z, m, n0 + j * 16 + fr, acc[j][r], acc[2 + j][r]);
                } else {
#pragma unroll
                    for (int j = 0; j < 4; ++j) f.epi(z, m, n0 + j * 16 + fr, acc[j][r]);
                } }
        }
        base += nun;
    }
}

struct FProj {
    __device__ int bz(int z) const { return z; }
    unsigned char* ws;
    __device__ int mcount(int) const { return NTOK; }
    __device__ const bf16* arow(int, int m) const { return (const bf16*)(ws + WS_H1) + (size_t)m * D; }
    __device__ void epi(int, int m, int n, float v) const {
        if (n < 512) { const int g = n >> 4, c = n & 15, b = m / SEQ, l = m % SEQ;
            ((bf16*)(ws + WS_AG))[((size_t)g * 1024 + b * NCH + l / CT) * 512 + (l % CT) * 16 + c] = (bf16)f2bf(v); }
        else if (n < 2048) ((bf16*)(ws + WS_CBV))[(size_t)m * 1536 + (n - 512)] = (bf16)f2bf(v);
        else ((bf16*)(ws + WS_GATES))[(size_t)m * 2048 + (n - 2048)] = (bf16)f2bf(sigmoidf_(v));
    }
    __device__ void epi2(int, int, int, float, float) const {}
};
struct FProjC {
    __device__ int bz(int z) const { return z; }
    unsigned char* ws;
    __device__ int mcount(int) const { return NCTX; }
    __device__ const bf16* arow(int, int m) const { return (const bf16*)(ws + WS_H1) + (size_t)(NTOK + m) * D; }
    __device__ void epi(int, int m, int n, float v) const { const int g = n >> 4, c = n & 15, b = m / CTXL, l = m % CTXL;
        ((bf16*)(ws + WS_UC))[((size_t)g * 128 + b * NCHC + l / CT) * 256 + (l % CT) * 16 + c] = (bf16)f2bf(v); }
    __device__ void epi2(int, int, int, float, float) const {}
};
struct FSloc {
    unsigned char* ws;
    __device__ int bz(int z) const { return z >> 3; }
    __device__ int mcount(int) const { return NCHT; }
    __device__ const bf16* arow(int z, int m) const { const int b = z & 7, g = z >> 4;
        return m < NCHC ? (const bf16*)(ws + WS_UC) + ((size_t)g * 128 + b * NCHC + m) * 256 : (const bf16*)(ws + WS_AG) + ((size_t)g * 1024 + b * NCH + (m - NCHC)) * 512; }
    __device__ void epi(int z, int m, int n, float v) const { ((float*)(ws + WS_SLOC))[((size_t)z * NCHT + m) * 128 + n] = v; }
    __device__ void epi2(int, int, int, float, float) const {}
};
struct FSsmOut {
    __device__ int bz(int z) const { return z; }
    unsigned char* ws;
    __device__ int mcount(int) const { return 1024; }
    __device__ const bf16* arow(int z, int m) const { return (const bf16*)(ws + WS_AG) + ((size_t)z * 1024 + m) * 512; }
    __device__ void epi(int z, int m, int n, float v) const { const int b = m / NCH, ch = m % NCH, tt = n >> 4, c = n & 15;
        ((bf16*)(ws + WS_YG))[((size_t)b * SEQ + ch * CT + tt) * 512 + z * 16 + c] = (bf16)f2bf(gelu_tanh(v)); }
    __device__ void epi2(int, int, int, float, float) const {}
};
struct FGlu {
    __device__ int bz(int z) const { return z; }
    unsigned char* ws;
    __device__ int mcount(int) const { return NTOK; }
    __device__ const bf16* arow(int, int m) const { return (const bf16*)(ws + WS_YG) + (size_t)m * 512; }
    __device__ void epi(int, int, int, float) const {}
    __device__ void epi2(int, int m, int n, float a, float b) const { ((bf16*)(ws + WS_GLU))[(size_t)m * 512 + (n >> 8) * 128 + (n & 255)] = (bf16)f2bf(a * sigmoidf_(b)); }
};
struct FMergeA {
    __device__ int bz(int z) const { return z; }
    unsigned char* ws;
    __device__ int mcount(int) const { return NTOK; }
    __device__ const bf16* arow(int, int m) const { return (const bf16*)(ws + WS_GLU) + (size_t)m * 512; }
    __device__ void epi(int, int m, int n, float v) const { const float ga = bf2f(((const bf16*)(ws + WS_GATES))[(size_t)m * 2048 + n]);
        ((bf16*)(ws + WS_MERGED))[(size_t)m * 1024 + n] = (bf16)f2bf(ga * v); }
    __device__ void epi2(int, int, int, float, float) const {}
};
struct FMergeB {
    __device__ int bz(int z) const { return z; }
    unsigned char* ws;
    __device__ int mcount(int) const { return NTOK; }
    __device__ const bf16* arow(int, int m) const { return (const bf16*)(ws + WS_CBR) + (size_t)m * 512; }
    __device__ void epi(int, int m, int n, float v) const { const float gb = bf2f(((const bf16*)(ws + WS_GATES))[(size_t)m * 2048 + 1024 + n]);
        bf16* o = (bf16*)(ws + WS_MERGED) + (size_t)m * 1024 + n; *o = (bf16)f2bf(bf2f(*o) + gb * v); }
    __device__ void epi2(int, int, int, float, float) const {}
};
struct FWo {
    __device__ int bz(int z) const { return z; }
    unsigned char* ws; const float* x;
    __device__ int mcount(int) const { return NTOK; }
    __device__ const bf16* arow(int, int m) const { return (const bf16*)(ws + WS_MERGED) + (size_t)m * 1024; }
    __device__ void epi(int, int m, int n, float v) const { const float g1 = ((const float*)(ws + WS_MOD))[(m / SEQ) * 6144 + 2048 + n];
        ((float*)(ws + WS_XL1))[(size_t)m * D + n] = x[(size_t)m * D + n] + g1 * v; }
    __device__ void epi2(int, int, int, float, float) const {}
};
struct FRouter {
    __device__ int bz(int z) const { return z; }
    unsigned char* ws;
    __device__ int mcount(int) const { return NTOK; }
    __device__ const bf16* arow(int, int m) const { return (const bf16*)(ws + WS_H2) + (size_t)m * D; }
    __device__ void epi(int, int m, int n, float v) const { ((float*)(ws + WS_SCORES))[(size_t)m * 256 + n] = sigmoidf_(v); }
    __device__ void epi2(int, int, int, float, float) const {}
};
struct FShared {
    __device__ int bz(int z) const { return z; }
    unsigned char* ws;
    __device__ int mcount(int) const { return NTOK; }
    __device__ const bf16* arow(int, int m) const { return (const bf16*)(ws + WS_H2) + (size_t)m * D; }
    __device__ void epi(int, int, int, float) const {}
    __device__ void epi2(int, int m, int n, float a, float b) const { ((bf16*)(ws + WS_HS))[(size_t)m * 256 + (n >> 8) * 128 + (n & 255)] = (bf16)f2bf(siluf_(a) * b); }
};
struct FSharedDown {
    __device__ int bz(int z) const { return z; }
    unsigned char* ws;
    __device__ int mcount(int) const { return NTOK; }
    __device__ const bf16* arow(int, int m) const { return (const bf16*)(ws + WS_HS) + (size_t)m * 256; }
    __device__ void epi(int, int m, int n, float v) const { const float g2 = ((const float*)(ws + WS_MOD))[(m / SEQ) * 6144 + 5120 + n];
        ((float*)(ws + WS_XL1))[(size_t)m * D + n] += g2 * v; }
    __device__ void epi2(int, int, int, float, float) const {}
};
struct FMoe1 {
    __device__ int bz(int z) const { return z; }
    unsigned char* ws; const int* stp;
    __device__ int mcount(int z) const { return (int)((const unsigned*)(ws + WS_CTL))[CW_CNT + z]; }
    __device__ const bf16* arow(int z, int m) const { const int ts = ((const int*)(ws + WS_LIST))[(size_t)z * LIST_CAP + m]; return (const bf16*)(ws + WS_H2) + (size_t)(ts >> 3) * D; }
    __device__ void epi(int, int, int, float) const {}
    __device__ void epi2(int z, int m, int n, float a, float b) const { const int st = stp[z];
        ((bf16*)(ws + WS_HBUF))[(size_t)(st + m) * 256 + (n >> 8) * 128 + (n & 255)] = (bf16)f2bf(siluf_(a) * b); }
};
struct FMoe2 {
    __device__ int bz(int z) const { return z; }
    unsigned char* ws; const int* stp;
    __device__ int mcount(int z) const { return (int)((const unsigned*)(ws + WS_CTL))[CW_CNT + z]; }
    __device__ const bf16* arow(int z, int m) const { const int st = stp[z]; return (const bf16*)(ws + WS_HBUF) + (size_t)(st + m) * 256; }
    __device__ void epi(int z, int m, int n, float v) const { const int ts = ((const int*)(ws + WS_LIST))[(size_t)z * LIST_CAP + m]; const float w = ((const float*)(ws + WS_TW))[ts];
        ((bf16*)(ws + WS_YSLOT))[(size_t)ts * D + n] = (bf16)f2bf(w * v); }
    __device__ void epi2(int, int, int, float, float) const {}
};

__device__ __forceinline__ void route_token(const Ptrs& P, int tok, int lane) {
    const f32x4 sc = ((const f32x4*)((const float*)(P.ws + WS_SCORES) + (size_t)tok * 256))[lane];
    const f32x4 bi = ((const f32x4*)P.in[23])[lane];
    float c0 = sc.x + bi.x, c1 = sc.y + bi.y, c2 = sc.z + bi.z, c3 = sc.w + bi.w;
    float t1 = fmaxf(c0, c1), t2 = fminf(c0, c1);
    { const float a = fmaxf(c2, c3), b = fminf(c2, c3); const float n1 = fmaxf(t1, a); const float n2 = fmaxf(fminf(t1, a), fmaxf(t2, b)); t1 = n1; t2 = n2; }
#pragma unroll
    for (int o = 1; o < 8; o <<= 1) { const float a = __shfl_xor(t1, o), b = __shfl_xor(t2, o); const float n1 = fmaxf(t1, a); const float n2 = fmaxf(fminf(t1, a), fmaxf(t2, b)); t1 = n1; t2 = n2; }
    const float gs = t1 + t2; const int myg = lane >> 3; int rank = 0;
#pragma unroll
    for (int j = 0; j < 8; ++j) { const float o = __shfl(gs, j * 8); rank += (o > gs || (o == gs && j < myg)) ? 1 : 0; }
    if (rank >= 4) { c0 = c1 = c2 = c3 = -INFINITY; }
    int sel_e = 0; float sel_s = 0.f; float ssum = 0.f;
#pragma unroll
    for (int k = 0; k < 8; ++k) {
        float bv = c0, bs = sc.x; int be = lane * 4;
        if (c1 > bv) { bv = c1; bs = sc.y; be = lane * 4 + 1; }
        if (c2 > bv) { bv = c2; bs = sc.z; be = lane * 4 + 2; }
        if (c3 > bv) { bv = c3; bs = sc.w; be = lane * 4 + 3; }
#pragma unroll
        for (int o = 1; o < 64; o <<= 1) { const float ov = __shfl_xor(bv, o), os = __shfl_xor(bs, o); const int oe = __shfl_xor(be, o);
            if (ov > bv || (ov == bv && oe < be)) { bv = ov; bs = os; be = oe; } }
        if (lane == k) { sel_e = be; sel_s = bs; }
        ssum += bs;
        if ((be >> 2) == lane) { const int q = be & 3; if (q == 0) c0 = -INFINITY; else if (q == 1) c1 = -INFINITY; else if (q == 2) c2 = -INFINITY; else c3 = -INFINITY; }
    }
    if (lane < 8) {
        const float w = sel_s / ssum * 2.5f;
        unsigned* cnt = (unsigned*)(P.ws + WS_CTL) + CW_CNT;
        const unsigned rk = atomicAdd(&cnt[sel_e], 1u);
        ((int*)(P.ws + WS_LIST))[(size_t)sel_e * LIST_CAP + rk] = tok * 8 + lane;
        ((float*)(P.ws + WS_TW))[tok * 8 + lane] = w;
    }
}
#define XB_TMO      128
#define XB_XCNT(j)  (256  + 64 * (j))
#define XB_XSUB(j)  (1280 + 64 * (j))
#define XB_XGEN(j)  (2304 + 64 * (j))
#define XB_TOP      3328
#define XB_TOPGEN   3392
#define XCD_BAR_WORDS 3456
#define XB_SPIN_CAP (1u << 18)
#define LAS __attribute__((address_space(3)))

__device__ __forceinline__ unsigned xb_ld(unsigned* p)              { return __hip_atomic_load(p, __ATOMIC_RELAXED, __HIP_MEMORY_SCOPE_AGENT); }
__device__ __forceinline__ unsigned xb_add(unsigned* p, unsigned v) { return __hip_atomic_fetch_add(p, v, __ATOMIC_RELAXED, __HIP_MEMORY_SCOPE_AGENT); }
__device__ __forceinline__ unsigned xb_xcc_id() { return (unsigned)__builtin_amdgcn_s_getreg((3 << 11) | 20) & 0xFu; }
#define XB_SPIN(cond, bar) do { unsigned _sp = 0; while (cond) { __builtin_amdgcn_s_sleep(1); \
    if ((++_sp & 255u) == 0u) { if (xb_ld(&(bar)[XB_TMO])) break; if (_sp > XB_SPIN_CAP) { atomicAdd(&(bar)[XB_TMO], 1u); break; } } } } while (0)

struct XcdBarrier {
    unsigned* bar; unsigned x;
    volatile LAS unsigned* st;
};

__device__ __forceinline__ XcdBarrier xcd_barrier_post(unsigned* bar, volatile LAS unsigned* st) {
    XcdBarrier b; b.bar = bar; b.x = xb_xcc_id(); b.st = st;
    if (threadIdx.x == 0) (void)xb_add(&bar[XB_XCNT(b.x)], 1u);
    return b;
}
__device__ __forceinline__ void xcd_barrier_complete(unsigned* bar, unsigned x, unsigned& nloc, unsigned& nx) {
    const unsigned G = gridDim.x * gridDim.y * gridDim.z;
    unsigned sum, cnt, mine, sp = 0u;
    for (;;) {
        sum = 0u; cnt = 0u; mine = 0u;
#pragma unroll
        for (unsigned j = 0; j < 16; ++j) { const unsigned c = xb_ld(&bar[XB_XCNT(j)]); sum += c; cnt += (c > 0u) ? 1u : 0u; mine = (j == x) ? c : mine; }
        if (sum == G) break;
        __builtin_amdgcn_s_sleep(1);
        if ((++sp & 255u) == 0u) { if (xb_ld(&bar[XB_TMO])) break; if (sp > XB_SPIN_CAP) { atomicAdd(&bar[XB_TMO], 1u); break; } }
    }
    nloc = mine > 0u ? mine : 1u; nx = cnt > 0u ? cnt : 1u;
}

__device__ __forceinline__ void xcd_barrier(const XcdBarrier& b) {
    asm volatile("s_waitcnt vmcnt(0)" ::: "memory");
    __syncthreads();
    if (threadIdx.x == 0) {
        unsigned* bar = b.bar;
        __builtin_amdgcn_s_waitcnt(0);
        unsigned nloc = b.st[0], nx = b.st[1];
        if (nloc == 0u) { xcd_barrier_complete(bar, b.x, nloc, nx); b.st[0] = nloc; b.st[1] = nx; }
        const unsigned old = xb_add(&bar[XB_XSUB(b.x)], 1u);
        const unsigned gen = old / nloc;
        if (old + 1u == (gen + 1u) * nloc) {
            __builtin_amdgcn_fence(__ATOMIC_RELEASE, "agent");
            asm volatile("s_waitcnt vmcnt(0)" ::: "memory");
            const unsigned og = xb_add(&bar[XB_TOP], 1u);
            const unsigned tg = og / nx;
            if (og + 1u == (tg + 1u) * nx) xb_add(&bar[XB_TOPGEN], 1u);
            else XB_SPIN(xb_ld(&bar[XB_TOPGEN]) == tg, bar);
            __builtin_amdgcn_fence(__ATOMIC_ACQUIRE, "agent");
            xb_add(&bar[XB_XGEN(b.x)], 1u);
            asm volatile("s_waitcnt vmcnt(0)" ::: "memory");
        } else {
            XB_SPIN(xb_ld(&bar[XB_XGEN(b.x)]) == gen, bar);
            __builtin_amdgcn_fence(__ATOMIC_ACQUIRE, "agent");
            asm volatile("s_waitcnt vmcnt(0)" ::: "memory");
        }
    }
    __syncthreads();
}

namespace pg8 {
#define PG8_LAS __attribute__((address_space(3)))
typedef unsigned short bf16_t;
typedef short bf16x8 __attribute__((ext_vector_type(8)));
typedef float f32x4 __attribute__((ext_vector_type(4)));
typedef unsigned u32x4 __attribute__((ext_vector_type(4)));
constexpr int BM = 256, BK = 64, HALF = 128, HTB = HALF * BK * 2  , STAGE_BYTES = 8 * HTB, NXCD = 8, WGM = 8;

__host__ __device__ __forceinline__ int lds_byte(int r, int c) { const int st = (r >> 4) * 2 + (c >> 5), rr = r & 15, cc = c & 31, ob = rr * 64 + cc * 2; return st * 1024 + (ob ^ (((ob >> 9) & 1) << 5)); }
__host__ __device__ __forceinline__ void stage_rc(int b, int& R, int& C) { const int st = b / 1024, sb = b % 1024, swz = sb ^ (((sb >> 9) & 1) << 5); R = (st >> 1) * 16 + swz / 64; C = (st & 1) * 32 + (swz % 64) / 2; }
__host__ __device__ __forceinline__ int perm32(int rho) { const int n = rho >> 4, i = rho & 15; return 8 * (i >> 2) + 4 * n + (i & 3); }

struct Unit { int pm, pn, e, mi, cnt, ord; };
struct Gemm { const bf16_t* A; const bf16_t* Bt; int M, N, K; };

struct StaticOrder {
    int nM, nN, nwg, G, c;
    __host__ __device__ __forceinline__ void init(int M, int N, int G_, int c_) { nM = M / BM; nN = N / BM; nwg = nM * nN; G = G_; c = c_; }
    __host__ __device__ __forceinline__ bool next(int i, Unit& u) const {
        const long L = (long)i * G + c; if (L >= nwg) return false;
        int wgid = (int)L; { const int q = nwg / NXCD, r = nwg % NXCD, xcd = wgid % NXCD, off = wgid / NXCD; wgid = (xcd < r ? xcd * (q + 1) : r * (q + 1) + (xcd - r) * q) + off; }
        const int nig = WGM * nN, gid = wgid / nig, fm = gid * WGM, gsz = (nM - fm) < WGM ? (nM - fm) : WGM;
        u.pm = fm + ((wgid % nig) % gsz); u.pn = (wgid % nig) / gsz; return true;
    }
    __device__ __forceinline__ void a_ready(const Unit&) const {}
    __device__ __forceinline__ void done(const Unit&) const {}
};

__device__ __forceinline__ unsigned cvt_pk_bf16(float lo, float hi) { unsigned r; asm volatile("v_cvt_pk_bf16_f32 %0, %1, %2" : "=v"(r) : "v"(lo), "v"(hi)); return r; }
__device__ __forceinline__ float sigm(float v) { return 1.0f / (1.0f + __expf(-v)); }
__device__ __forceinline__ u32x4 pack8(const f32x4 a, const f32x4 b) { u32x4 w; w.x = cvt_pk_bf16(a[0], a[1]); w.y = cvt_pk_bf16(a[2], a[3]); w.z = cvt_pk_bf16(b[0], b[1]); w.w = cvt_pk_bf16(b[2], b[3]); return w; }
__device__ __forceinline__ float bfl(unsigned w) { return __builtin_bit_cast(float, w << 16); }
__device__ __forceinline__ float bfh(unsigned w) { return __builtin_bit_cast(float, w & 0xffff0000u); }

struct ProjOrder {
    StaticOrder so; int G, c;
    __device__ __forceinline__ void init(int G_, int c_) { so.init(NTOK, INC, G_, c_); G = G_; c = c_; }
    __device__ __forceinline__ bool next(int i, Unit& u) const { u.e = 0; u.mi = 0; u.cnt = 0; u.ord = i;
        if (so.next(i, u)) return true;
        const long L = (long)i * G + c - so.nwg; if (L < 0 || L >= 16) return false; u.pm = 64 + (int)(L >> 1); u.pn = (int)(L & 1); return true; }
    __device__ __forceinline__ void a_ready(const Unit&) const {}
    __device__ __forceinline__ void done(const Unit&) const {}
};
struct PlainOrder {
    StaticOrder so;
    __device__ __forceinline__ void init(int M, int N, int G_, int c_) { so.init(M, N, G_, c_); }
    __device__ __forceinline__ bool next(int i, Unit& u) const { u.e = 0; u.mi = 0; u.cnt = 0; u.ord = i; return so.next(i, u); }
    __device__ __forceinline__ void a_ready(const Unit&) const {}
    __device__ __forceinline__ void done(const Unit&) const {}
};
struct SsmOrder {
    int G, c;
    __device__ __forceinline__ bool next(int i, Unit& u) const { const long L = (long)i * G + c; if (L >= 128) return false; u.pm = (int)L; u.pn = (int)(L >> 2); u.e = 0; u.mi = 0; u.cnt = 0; u.ord = i; return true; }
    __device__ __forceinline__ void a_ready(const Unit&) const {}
    __device__ __forceinline__ void done(const Unit&) const {}
};
struct MoeOrder {
    int nn, nwg, G, c; const PG8_LAS int* ts; const unsigned* cntp;
    __device__ __forceinline__ void init(int nn_, int G_, int c_, const PG8_LAS int* ts_, const unsigned* cnt_) { nn = nn_; G = G_; c = c_; ts = ts_; cntp = cnt_; nwg = ts_[256] * nn_; }
    __device__ __forceinline__ bool next(int i, Unit& u) const {
        const long L = (long)i * G + c; if (L >= nwg) return false;
        int wgid = (int)L; { const int q = nwg / NXCD, r = nwg % NXCD, xcd = wgid % NXCD, off = wgid / NXCD; wgid = (xcd < r ? xcd * (q + 1) : r * (q + 1) + (xcd - r) * q) + off; }
        const int T = wgid / nn, j = wgid % nn;
        int lo = 0, hi = 257;
#pragma unroll 1
        while (lo < hi) { const int mid = (lo + hi) >> 1; if (ts[mid] <= T) lo = mid + 1; else hi = mid; }
        const int e = __builtin_amdgcn_readfirstlane(lo - 1);
        u.e = e; u.mi = __builtin_amdgcn_readfirstlane(T - ts[e]); u.pm = __builtin_amdgcn_readfirstlane(T); u.pn = e * nn + j; u.ord = i;
        u.cnt = __builtin_amdgcn_readfirstlane((int)cntp[e]); return true; }
    __device__ __forceinline__ void a_ready(const Unit&) const {}
    __device__ __forceinline__ void done(const Unit&) const {}
};
struct LdsGather { const PG8_LAS unsigned* offs; __device__ __forceinline__ unsigned row_off(const Unit& u, int r) const { return offs[u.ord * 256 + r]; } };

struct EpiProj {
    static constexpr bool PERM = true, AFTER_DRAIN = false; unsigned char* ws;
    __device__ __forceinline__ void operator()(const f32x4 (&acc)[2][2][4][2], const Unit& u, int wr, int wc, int fr, int fq) const {
#pragma unroll
        for (int ai = 0; ai < 2; ++ai)
#pragma unroll
            for (int m = 0; m < 4; ++m) { const int row = u.pm * BM + ai * HALF + wr * 64 + m * 16 + fr;
#pragma unroll
                for (int bj = 0; bj < 2; ++bj) { const int col = u.pn * BM + bj * HALF + wc * 32 + 8 * fq; f32x4 v0 = acc[ai][bj][m][0], v1 = acc[ai][bj][m][1];
                    bf16_t* dst;
                    if (u.pn < 2) { const int g = col >> 4, c0 = col & 15;
                        if (u.pm < 64) { const int b = row >> 11, l = row & 2047; dst = (bf16_t*)(ws + WS_AG) + ((size_t)g * 1024 + b * NCH + (l >> 4)) * 512 + (l & 15) * 16 + c0; }
                        else { const int r2 = row - NTOK, b = r2 >> 8, l = r2 & 255; dst = (bf16_t*)(ws + WS_UC) + ((size_t)g * 128 + b * NCHC + (l >> 4)) * 256 + (l & 15) * 16 + c0; } }
                    else if (u.pn < 8) dst = (bf16_t*)(ws + WS_CBV) + (size_t)row * 1536 + (col - 512);
                    else { dst = (bf16_t*)(ws + WS_GATES) + (size_t)row * 2048 + (col - 2048);
#pragma unroll
                        for (int q = 0; q < 4; ++q) { v0[q] = sigm(v0[q]); v1[q] = sigm(v1[q]); } }
                    *(u32x4*)dst = pack8(v0, v1); } }
    }
};
struct EpiSsmOut {
    static constexpr bool PERM = true, AFTER_DRAIN = false; unsigned char* ws;
    __device__ __forceinline__ void operator()(const f32x4 (&acc)[2][2][4][2], const Unit& u, int wr, int wc, int fr, int fq) const {
        const int g = u.pn;
#pragma unroll
        for (int ai = 0; ai < 2; ++ai)
#pragma unroll
            for (int m = 0; m < 4; ++m) { const int rl = (u.pm & 3) * BM + ai * HALF + wr * 64 + m * 16 + fr; const int b = rl >> 7, ch = rl & 127;
#pragma unroll
                for (int bj = 0; bj < 2; ++bj) { const int nc = bj * HALF + wc * 32 + 8 * fq, tt = nc >> 4, c0 = nc & 15; f32x4 v0 = acc[ai][bj][m][0], v1 = acc[ai][bj][m][1];
#pragma unroll
                    for (int q = 0; q < 4; ++q) { const float a = v0[q], bq = v1[q];
                        v0[q] = a * sigm(1.5957691216057308f * (a + 0.044715f * a * a * a)); v1[q] = bq * sigm(1.5957691216057308f * (bq + 0.044715f * bq * bq * bq)); }
                    *(u32x4*)((bf16_t*)(ws + WS_YG) + ((size_t)b * SEQ + ch * CT + tt) * 512 + g * 16 + c0) = pack8(v0, v1); } }
    }
};
struct EpiGlu {
    static constexpr bool PERM = true, AFTER_DRAIN = false; unsigned char* ws;
    __device__ __forceinline__ void operator()(const f32x4 (&acc)[2][2][4][2], const Unit& u, int wr, int wc, int fr, int fq) const {
#pragma unroll
        for (int ai = 0; ai < 2; ++ai)
#pragma unroll
            for (int m = 0; m < 4; ++m) { const int row = u.pm * BM + ai * HALF + wr * 64 + m * 16 + fr; f32x4 o[2];
#pragma unroll
                for (int n = 0; n < 2; ++n)
#pragma unroll
                    for (int q = 0; q < 4; ++q) o[n][q] = acc[ai][0][m][n][q] * sigm(acc[ai][1][m][n][q]);
                *(u32x4*)((bf16_t*)(ws + WS_GLU) + (size_t)row * 512 + u.pn * 128 + wc * 32 + 8 * fq) = pack8(o[0], o[1]); }
    }
};
template <int SECOND> struct EpiMerge {
    static constexpr bool PERM = true, AFTER_DRAIN = false; unsigned char* ws;
    __device__ __forceinline__ void operator()(const f32x4 (&acc)[2][2][4][2], const Unit& u, int wr, int wc, int fr, int fq) const {
#pragma unroll
        for (int ai = 0; ai < 2; ++ai)
#pragma unroll
            for (int m = 0; m < 4; ++m) { const int row = u.pm * BM + ai * HALF + wr * 64 + m * 16 + fr;
#pragma unroll
                for (int bj = 0; bj < 2; ++bj) { const int col = u.pn * BM + bj * HALF + wc * 32 + 8 * fq;
                    const u32x4 gt = *(const u32x4*)((const bf16_t*)(ws + WS_GATES) + (size_t)row * 2048 + SECOND * 1024 + col);
                    bf16_t* dst = (bf16_t*)(ws + WS_MERGED) + (size_t)row * 1024 + col;
                    f32x4 v0 = acc[ai][bj][m][0], v1 = acc[ai][bj][m][1];
                    v0[0] *= bfl(gt.x); v0[1] *= bfh(gt.x); v0[2] *= bfl(gt.y); v0[3] *= bfh(gt.y); v1[0] *= bfl(gt.z); v1[1] *= bfh(gt.z); v1[2] *= bfl(gt.w); v1[3] *= bfh(gt.w);
                    if (SECOND) { const u32x4 pv = *(const u32x4*)dst;
                        v0[0] += bfl(pv.x); v0[1] += bfh(pv.x); v0[2] += bfl(pv.y); v0[3] += bfh(pv.y); v1[0] += bfl(pv.z); v1[1] += bfh(pv.z); v1[2] += bfl(pv.w); v1[3] += bfh(pv.w); }
                    *(u32x4*)dst = pack8(v0, v1); }
                asm volatile("" ::: "memory"); }
    }
};
struct EpiWo {
    static constexpr bool PERM = false, AFTER_DRAIN = false; unsigned char* ws; const float* x;
    __device__ __forceinline__ void operator()(const f32x4 (&acc)[2][2][4][2], const Unit& u, int wr, int wc, int fr, int fq) const {
        const float* g1 = (const float*)(ws + WS_MOD) + (u.pm >> 3) * 6144 + 2048;
#pragma unroll
        for (int ai = 0; ai < 2; ++ai)
#pragma unroll
            for (int m = 0; m < 4; ++m) { const size_t row = (size_t)(u.pm * BM + ai * HALF + wr * 64 + m * 16 + fr);
#pragma unroll
                for (int bj = 0; bj < 2; ++bj)
#pragma unroll
                    for (int n = 0; n < 2; ++n) { const int col = u.pn * BM + bj * HALF + wc * 32 + 16 * n + 4 * fq;
                        const f32x4 xv = *(const f32x4*)(x + row * D + col), gv = *(const f32x4*)(g1 + col);
                        *(f32x4*)((float*)(ws + WS_XL1) + row * D + col) = xv + gv * acc[ai][bj][m][n]; }
                asm volatile("" ::: "memory"); }
    }
};
struct EpiSharedDown {
    static constexpr bool PERM = false, AFTER_DRAIN = false; unsigned char* ws;
    __device__ __forceinline__ void operator()(const f32x4 (&acc)[2][2][4][2], const Unit& u, int wr, int wc, int fr, int fq) const {
        const float* g2 = (const float*)(ws + WS_MOD) + (u.pm >> 3) * 6144 + 5120;
#pragma unroll
        for (int ai = 0; ai < 2; ++ai)
#pragma unroll
            for (int m = 0; m < 4; ++m) { const size_t row = (size_t)(u.pm * BM + ai * HALF + wr * 64 + m * 16 + fr);
#pragma unroll
                for (int bj = 0; bj < 2; ++bj)
#pragma unroll
                    for (int n = 0; n < 2; ++n) { const int col = u.pn * BM + bj * HALF + wc * 32 + 16 * n + 4 * fq;
                        float* p = (float*)(ws + WS_XL1) + row * D + col; const f32x4 gv = *(const f32x4*)(g2 + col);
                        *(f32x4*)p = *(const f32x4*)p + gv * acc[ai][bj][m][n]; }
                asm volatile("" ::: "memory"); }
    }
};
struct EpiRS {
    static constexpr bool PERM = true, AFTER_DRAIN = false; unsigned char* ws;
    __device__ __forceinline__ void operator()(const f32x4 (&acc)[2][2][4][2], const Unit& u, int wr, int wc, int fr, int fq) const {
#pragma unroll
        for (int ai = 0; ai < 2; ++ai)
#pragma unroll
            for (int m = 0; m < 4; ++m) { const size_t row = (size_t)(u.pm * BM + ai * HALF + wr * 64 + m * 16 + fr);
                if (u.pn == 0) {
#pragma unroll
                    for (int bj = 0; bj < 2; ++bj)
#pragma unroll
                        for (int n = 0; n < 2; ++n) { f32x4 v = acc[ai][bj][m][n];
#pragma unroll
                            for (int q = 0; q < 4; ++q) v[q] = sigm(v[q]);
                            *(f32x4*)((float*)(ws + WS_SCORES) + row * 256 + bj * HALF + wc * 32 + 8 * fq + 4 * n) = v; }
                } else { f32x4 o[2];
#pragma unroll
                    for (int n = 0; n < 2; ++n)
#pragma unroll
                        for (int q = 0; q < 4; ++q) { const float a = acc[ai][0][m][n][q]; o[n][q] = a * sigm(a) * acc[ai][1][m][n][q]; }
                    *(u32x4*)((bf16_t*)(ws + WS_HS) + row * 256 + (u.pn - 1) * 128 + wc * 32 + 8 * fq) = pack8(o[0], o[1]); } }
    }
};
struct EpiMoe1 {
    static constexpr bool PERM = true, AFTER_DRAIN = false; unsigned char* ws;
    __device__ __forceinline__ void operator()(const f32x4 (&acc)[2][2][4][2], const Unit& u, int wr, int wc, int fr, int fq) const {
#pragma unroll
        for (int ai = 0; ai < 2; ++ai)
#pragma unroll
            for (int m = 0; m < 4; ++m) { const size_t row = (size_t)(u.pm * BM + ai * HALF + wr * 64 + m * 16 + fr); f32x4 o[2];
#pragma unroll
                for (int n = 0; n < 2; ++n)
#pragma unroll
                    for (int q = 0; q < 4; ++q) { const float a = acc[ai][0][m][n][q]; o[n][q] = a * sigm(a) * acc[ai][1][m][n][q]; }
                *(u32x4*)((bf16_t*)(ws + WS_HBUF) + row * 256 + (u.pn & 1) * 128 + wc * 32 + 8 * fq) = pack8(o[0], o[1]); }
    }
};
struct EpiMoe2 {
    static constexpr bool PERM = true, AFTER_DRAIN = false; unsigned char* ws;
    __device__ __forceinline__ void operator()(const f32x4 (&acc)[2][2][4][2], const Unit& u, int wr, int wc, int fr, int fq) const {
        const int* list = (const int*)(ws + WS_LIST) + (size_t)u.e * LIST_CAP + u.mi * BM; const float* tw = (const float*)(ws + WS_TW);
#pragma unroll
        for (int ai = 0; ai < 2; ++ai)
#pragma unroll
            for (int m = 0; m < 4; ++m) { const int rl = ai * HALF + wr * 64 + m * 16 + fr;
                if (u.mi * BM + rl < u.cnt) { const int ts = list[rl]; const float w = tw[ts];
#pragma unroll
                    for (int bj = 0; bj < 2; ++bj)
                        *(u32x4*)((bf16_t*)(ws + WS_YSLOT) + (size_t)ts * D + (u.pn & 3) * BM + bj * HALF + wc * 32 + 8 * fq) = pack8(acc[ai][bj][m][0] * w, acc[ai][bj][m][1] * w); }
                if (m & 1) asm volatile("" ::: "memory"); }
    }
};
template <class Epi, class Sched, bool ALIGN_EPI = false, bool SP2 = false>
__device__ __forceinline__ void gemm_phase(PG8_LAS unsigned char* lds, const Gemm g, const Sched& S, const Epi& E) {
    int tid_ = threadIdx.x; asm volatile("" : "+v"(tid_));
    const int tid = tid_, wid = __builtin_amdgcn_readfirstlane(tid >> 6), lane = tid & 63, wr = wid >> 2, wc = wid & 3, fr = lane & 15, fq = lane >> 4;
    const int K = g.K, nt = K / BK;
    unsigned voffA[2], voffB[2];
#pragma unroll
    for (int i = 0; i < 2; ++i) { int R, C; stage_rc(tid * 16 + i * 8192, R, C); const int Rb = Epi::PERM ? ((R & ~31) + perm32(R & 31)) : R;
        voffA[i] = (unsigned)(R * K + C) * 2u; voffB[i] = (unsigned)(Rb * K + C) * 2u; }
    const size_t kstep = (size_t)(BK * 2);
    const size_t hstep = (size_t)HALF * K * 2;
    const size_t tstep = 2 * hstep;
    const unsigned ldsw = (unsigned)wid * 1024u;
    const int aoff = lds_byte(wr * 64 + fr, fq * 8), boff = lds_byte(wc * 32 + fr, fq * 8);
#define PG8_SA(b, h) (((b) * 2 + (h)) * HTB)
#define PG8_SB(b, h) ((4 + (b) * 2 + (h)) * HTB)
#define PG8_STAGE(bufoff, gbase, voff) do { _Pragma("unroll") for (int _i = 0; _i < 2; ++_i) \
        __builtin_amdgcn_global_load_lds((const unsigned*)((const char*)(gbase) + (voff)[_i]), (PG8_LAS unsigned*)(lds + (bufoff) + ldsw + _i * 8192), 16, 0, 0); } while (0)
#define PG8_LDA(dst, b, h) do { _Pragma("unroll") for (int m = 0; m < 4; ++m) _Pragma("unroll") for (int k = 0; k < 2; ++k) dst[m][k] = *(const PG8_LAS bf16x8*)(lds + PG8_SA(b, h) + aoff + m * 2048 + k * 1024); } while (0)
#define PG8_LDB(dst, b, h) do { _Pragma("unroll") for (int n = 0; n < 2; ++n) _Pragma("unroll") for (int k = 0; k < 2; ++k) dst[n][k] = *(const PG8_LAS bf16x8*)(lds + PG8_SB(b, h) + boff + n * 2048 + k * 1024); } while (0)
#define PG8_MMA(ai, bj, At, Bt) do { __builtin_amdgcn_s_setprio(1); _Pragma("unroll") for (int m = 0; m < 4; ++m) _Pragma("unroll") for (int n = 0; n < 2; ++n) _Pragma("unroll") for (int k = 0; k < 2; ++k) \
        acc[ai][bj][m][n] = __builtin_amdgcn_mfma_f32_16x16x32_bf16(Bt[n][k], At[m][k], acc[ai][bj][m][n], 0, 0, 0); __builtin_amdgcn_s_setprio(0); } while (0)
#define PG8_WAIT_V(n) asm volatile("s_waitcnt vmcnt(" #n ")" ::: "memory")
#define PG8_WAIT_L(n) asm volatile("s_waitcnt lgkmcnt(" #n ")" ::: "memory")
#define PG8_BAR __builtin_amdgcn_s_barrier()
#define PG8_SCHED __builtin_amdgcn_sched_barrier(0)
    Unit cur, nxt; int ui = 0;
    if (!S.next(0, cur)) return;
    f32x4 acc[2][2][4][2];
#pragma unroll
    for (int a = 0; a < 2; ++a)
#pragma unroll
        for (int b = 0; b < 2; ++b)
#pragma unroll
            for (int m = 0; m < 4; ++m)
#pragma unroll
                for (int n = 0; n < 2; ++n) acc[a][b][m][n] = (f32x4){0.f, 0.f, 0.f, 0.f};
    bf16x8 At[4][2], B0[2][2], B1[2][2];
    const char* cA = (const char*)g.A + (size_t)cur.pm * tstep; const char* cB = (const char*)g.Bt + (size_t)cur.pn * tstep;
    S.a_ready(cur);
    if constexpr (SP2) {
        PG8_STAGE(PG8_SB(0, 0), cB, voffB); PG8_STAGE(PG8_SB(0, 1), cB + hstep, voffB); PG8_STAGE(PG8_SA(0, 0), cA, voffA); PG8_STAGE(PG8_SA(0, 1), cA + hstep, voffA);
        if (wr == 1) PG8_BAR;
        PG8_WAIT_V(2); PG8_BAR;
        PG8_STAGE(PG8_SB(1, 0), cB + kstep, voffB); PG8_STAGE(PG8_SA(1, 0), cA + kstep, voffA); PG8_STAGE(PG8_SB(1, 1), cB + hstep + kstep, voffB);
        PG8_WAIT_V(6); PG8_BAR;
    } else {
        PG8_STAGE(PG8_SB(0, 0), cB, voffB); PG8_STAGE(PG8_SA(0, 0), cA, voffA); PG8_STAGE(PG8_SB(0, 1), cB + hstep, voffB); PG8_STAGE(PG8_SA(0, 1), cA + hstep, voffA);
        if (wr == 1) PG8_BAR;
        PG8_WAIT_V(4); PG8_BAR;
        PG8_STAGE(PG8_SB(1, 0), cB + kstep, voffB); PG8_STAGE(PG8_SA(1, 0), cA + kstep, voffA); PG8_STAGE(PG8_SB(1, 1), cB + hstep + kstep, voffB);
        PG8_WAIT_V(6); PG8_BAR;
    }
    for (;;) {
        const bool has_next = S.next(ui + 1, nxt);
        const char* nA = has_next ? (const char*)g.A + (size_t)nxt.pm * tstep : cA; const char* nB = has_next ? (const char*)g.Bt + (size_t)nxt.pn * tstep : cB;
        for (int t = 0; t < nt; t += 2) {
            const bool last = (t == nt - 2);
            const char* a1 = cA + (size_t)(t + 1) * kstep;
            const char* a2 = last ? nA : cA + (size_t)(t + 2) * kstep; const char* b2 = last ? nB : cB + (size_t)(t + 2) * kstep;
            const char* a3 = a2 + kstep; const char* b3 = b2 + kstep;
            if (last && has_next) S.a_ready(nxt);
            if constexpr (SP2) {
            PG8_LDB(B0, 0, 0); PG8_LDB(B1, 0, 1); PG8_SCHED; PG8_LDA(At, 0, 0); PG8_STAGE(PG8_SA(1, 1), a1 + hstep, voffA);
            PG8_WAIT_V(8); PG8_WAIT_L(0); PG8_BAR; PG8_MMA(0, 0, At, B0); PG8_MMA(0, 1, At, B1); PG8_BAR; PG8_SCHED;
            PG8_LDA(At, 0, 1); PG8_STAGE(PG8_SB(0, 0), b2, voffB); PG8_STAGE(PG8_SB(0, 1), b2 + hstep, voffB); PG8_STAGE(PG8_SA(0, 0), a2, voffA);
            PG8_WAIT_V(8); PG8_WAIT_L(0); PG8_BAR; PG8_MMA(1, 0, At, B0); PG8_MMA(1, 1, At, B1); PG8_BAR; PG8_SCHED;
            PG8_LDB(B0, 1, 0); PG8_LDB(B1, 1, 1); PG8_SCHED; PG8_LDA(At, 1, 0); PG8_STAGE(PG8_SA(0, 1), a2 + hstep, voffA);
            PG8_WAIT_V(8); PG8_WAIT_L(0); PG8_BAR; PG8_MMA(0, 0, At, B0); PG8_MMA(0, 1, At, B1); PG8_BAR; PG8_SCHED;
            PG8_LDA(At, 1, 1); PG8_STAGE(PG8_SB(1, 0), b3, voffB); PG8_STAGE(PG8_SB(1, 1), b3 + hstep, voffB); PG8_STAGE(PG8_SA(1, 0), a3, voffA);
            PG8_WAIT_V(8); PG8_WAIT_L(0); PG8_BAR; PG8_MMA(1, 0, At, B0); PG8_MMA(1, 1, At, B1); PG8_BAR; PG8_SCHED;
            } else {
            PG8_LDB(B0, 0, 0); PG8_SCHED; PG8_LDA(At, 0, 0); PG8_STAGE(PG8_SA(1, 1), a1 + hstep, voffA);
            PG8_WAIT_L(8); PG8_BAR; PG8_WAIT_L(0); PG8_MMA(0, 0, At, B0); PG8_BAR; PG8_SCHED;
            PG8_LDB(B1, 0, 1); PG8_STAGE(PG8_SB(0, 0), b2, voffB);
            PG8_BAR; PG8_WAIT_L(0); PG8_MMA(0, 1, At, B1); PG8_BAR;
            PG8_LDA(At, 0, 1); PG8_STAGE(PG8_SA(0, 0), a2, voffA);
            PG8_BAR; PG8_WAIT_L(0); PG8_MMA(1, 0, At, B0); PG8_BAR; PG8_SCHED;
            PG8_STAGE(PG8_SB(0, 1), b2 + hstep, voffB);
            PG8_WAIT_V(6); PG8_BAR; PG8_MMA(1, 1, At, B1); PG8_BAR;
            PG8_LDB(B0, 1, 0); PG8_SCHED; PG8_LDA(At, 1, 0); PG8_STAGE(PG8_SA(0, 1), a2 + hstep, voffA);
            PG8_WAIT_L(8); PG8_BAR; PG8_WAIT_L(0); PG8_MMA(0, 0, At, B0); PG8_BAR; PG8_SCHED;
            PG8_LDB(B1, 1, 1); PG8_STAGE(PG8_SB(1, 0), b3, voffB);
            PG8_BAR; PG8_WAIT_L(0); PG8_MMA(0, 1, At, B1); PG8_BAR;
            PG8_LDA(At, 1, 1); PG8_STAGE(PG8_SA(1, 0), a3, voffA);
            PG8_BAR; PG8_WAIT_L(0); PG8_MMA(1, 0, At, B0); PG8_BAR; PG8_SCHED;
            PG8_STAGE(PG8_SB(1, 1), b3 + hstep, voffB);
            PG8_WAIT_V(6); PG8_BAR; PG8_MMA(1, 1, At, B1); PG8_BAR;
            }
        }
        if constexpr (ALIGN_EPI) { if (wr == 0) PG8_BAR; }
        if constexpr (!Epi::AFTER_DRAIN) { E(acc, cur, wr, wc, fr, fq); S.done(cur); }
        if (!has_next) break;
#pragma unroll
        for (int a = 0; a < 2; ++a)
#pragma unroll
            for (int b = 0; b < 2; ++b)
#pragma unroll
                for (int m = 0; m < 4; ++m)
#pragma unroll
                    for (int n = 0; n < 2; ++n) acc[a][b][m][n] = (f32x4){0.f, 0.f, 0.f, 0.f};
        cur = nxt; cA = nA; cB = nB; ++ui;
        if constexpr (ALIGN_EPI) { if (wr == 1) PG8_BAR; }
    }
    PG8_WAIT_V(0);
    if constexpr (!ALIGN_EPI) { if (wr == 0) PG8_BAR; }
    PG8_BAR;
    if constexpr (Epi::AFTER_DRAIN) { E.fused(acc, cur, wr, wc, fr, fq, lds, wid, lane); S.done(cur); }
#undef PG8_SA
#undef PG8_SB
#undef PG8_STAGE
#undef PG8_LDA
#undef PG8_LDB
#undef PG8_MMA
#undef PG8_WAIT_V
#undef PG8_WAIT_L
#undef PG8_BAR
#undef PG8_SCHED
}


template <class Epi, class Sched, class Gather, bool ALIGN_EPI = false>
__device__ __forceinline__ void gemm_phase_gather(PG8_LAS unsigned char* lds, const Gemm g, const Sched& S, const Epi& E, const Gather& GA) {
    constexpr bool SP2 = true;
    int tid_ = threadIdx.x; asm volatile("" : "+v"(tid_));
    const int tid = tid_, wid = __builtin_amdgcn_readfirstlane(tid >> 6), lane = tid & 63, wr = wid >> 2, wc = wid & 3, fr = lane & 15, fq = lane >> 4;
    const int K = g.K, nt = K / BK;
    unsigned voffB[2]; int gR[2], gC[2];
#pragma unroll
    for (int i = 0; i < 2; ++i) { int R, C; stage_rc(tid * 16 + i * 8192, R, C); const int Rb = Epi::PERM ? ((R & ~31) + perm32(R & 31)) : R;
        gR[i] = R; gC[i] = C; voffB[i] = (unsigned)(Rb * K + C) * 2u; }
    unsigned vc[2][2], vn[2][2];
    const size_t kstep = (size_t)(BK * 2);
    const size_t hstep = (size_t)HALF * K * 2;
    const size_t tstep = 2 * hstep;
    const unsigned ldsw = (unsigned)wid * 1024u;
    const int aoff = lds_byte(wr * 64 + fr, fq * 8), boff = lds_byte(wc * 32 + fr, fq * 8);
#define PG8_SA(b, h) (((b) * 2 + (h)) * HTB)
#define PG8_SB(b, h) ((4 + (b) * 2 + (h)) * HTB)
#define PG8_STAGE(bufoff, gbase, voff) do { _Pragma("unroll") for (int _i = 0; _i < 2; ++_i) \
        __builtin_amdgcn_global_load_lds((const unsigned*)((const char*)(gbase) + (voff)[_i]), (PG8_LAS unsigned*)(lds + (bufoff) + ldsw + _i * 8192), 16, 0, 0); } while (0)
#define PG8_LDA(dst, b, h) do { _Pragma("unroll") for (int m = 0; m < 4; ++m) _Pragma("unroll") for (int k = 0; k < 2; ++k) dst[m][k] = *(const PG8_LAS bf16x8*)(lds + PG8_SA(b, h) + aoff + m * 2048 + k * 1024); } while (0)
#define PG8_LDB(dst, b, h) do { _Pragma("unroll") for (int n = 0; n < 2; ++n) _Pragma("unroll") for (int k = 0; k < 2; ++k) dst[n][k] = *(const PG8_LAS bf16x8*)(lds + PG8_SB(b, h) + boff + n * 2048 + k * 1024); } while (0)
#define PG8_MMA(ai, bj, At, Bt) do { __builtin_amdgcn_s_setprio(1); _Pragma("unroll") for (int m = 0; m < 4; ++m) _Pragma("unroll") for (int n = 0; n < 2; ++n) _Pragma("unroll") for (int k = 0; k < 2; ++k) \
        acc[ai][bj][m][n] = __builtin_amdgcn_mfma_f32_16x16x32_bf16(Bt[n][k], At[m][k], acc[ai][bj][m][n], 0, 0, 0); __builtin_amdgcn_s_setprio(0); } while (0)
#define PG8_WAIT_V(n) asm volatile("s_waitcnt vmcnt(" #n ")" ::: "memory")
#define PG8_WAIT_L(n) asm volatile("s_waitcnt lgkmcnt(" #n ")" ::: "memory")
#define PG8_BAR __builtin_amdgcn_s_barrier()
#define PG8_SCHED __builtin_amdgcn_sched_barrier(0)
    Unit cur, nxt; int ui = 0;
    if (!S.next(0, cur)) return;
    f32x4 acc[2][2][4][2];
#pragma unroll
    for (int a = 0; a < 2; ++a)
#pragma unroll
        for (int b = 0; b < 2; ++b)
#pragma unroll
            for (int m = 0; m < 4; ++m)
#pragma unroll
                for (int n = 0; n < 2; ++n) acc[a][b][m][n] = (f32x4){0.f, 0.f, 0.f, 0.f};
    bf16x8 At[4][2], B0[2][2], B1[2][2];
    const char* const gA = (const char*)g.A; const char* cB = (const char*)g.Bt + (size_t)cur.pn * tstep;
#pragma unroll
    for (int h = 0; h < 2; ++h)
#pragma unroll
        for (int i = 0; i < 2; ++i) vc[h][i] = GA.row_off(cur, h * HALF + gR[i]) + (unsigned)gC[i] * 2u;
    S.a_ready(cur);
    if constexpr (SP2) {
        PG8_STAGE(PG8_SB(0, 0), cB, voffB); PG8_STAGE(PG8_SB(0, 1), cB + hstep, voffB); PG8_STAGE(PG8_SA(0, 0), gA, vc[0]); PG8_STAGE(PG8_SA(0, 1), gA, vc[1]);
        if (wr == 1) PG8_BAR;
        PG8_WAIT_V(2); PG8_BAR;
        PG8_STAGE(PG8_SB(1, 0), cB + kstep, voffB); PG8_STAGE(PG8_SA(1, 0), gA + kstep, vc[0]); PG8_STAGE(PG8_SB(1, 1), cB + hstep + kstep, voffB);
        PG8_WAIT_V(6); PG8_BAR;
    }
    for (;;) {
        const bool has_next = S.next(ui + 1, nxt);
        const char* nB = has_next ? (const char*)g.Bt + (size_t)nxt.pn * tstep : cB;
#pragma unroll
        for (int h = 0; h < 2; ++h)
#pragma unroll
            for (int i = 0; i < 2; ++i) vn[h][i] = has_next ? GA.row_off(nxt, h * HALF + gR[i]) + (unsigned)gC[i] * 2u : vc[h][i];
        for (int t = 0; t < nt; t += 2) {
            const bool last = (t == nt - 2);
            const char* a1 = gA + (size_t)(t + 1) * kstep;
            const char* a2 = last ? gA : gA + (size_t)(t + 2) * kstep; const char* b2 = last ? nB : cB + (size_t)(t + 2) * kstep;
            unsigned v2[2][2];
#pragma unroll
            for (int h = 0; h < 2; ++h)
#pragma unroll
                for (int i = 0; i < 2; ++i) v2[h][i] = last ? vn[h][i] : vc[h][i];
            const char* a3 = a2 + kstep; const char* b3 = b2 + kstep;
            if (last && has_next) S.a_ready(nxt);
            if constexpr (SP2) {
            PG8_LDB(B0, 0, 0); PG8_LDB(B1, 0, 1); PG8_SCHED; PG8_LDA(At, 0, 0); PG8_STAGE(PG8_SA(1, 1), a1, vc[1]);
            PG8_WAIT_V(8); PG8_WAIT_L(0); PG8_BAR; PG8_MMA(0, 0, At, B0); PG8_MMA(0, 1, At, B1); PG8_BAR; PG8_SCHED;
            PG8_LDA(At, 0, 1); PG8_STAGE(PG8_SB(0, 0), b2, voffB); PG8_STAGE(PG8_SB(0, 1), b2 + hstep, voffB); PG8_STAGE(PG8_SA(0, 0), a2, v2[0]);
            PG8_WAIT_V(8); PG8_WAIT_L(0); PG8_BAR; PG8_MMA(1, 0, At, B0); PG8_MMA(1, 1, At, B1); PG8_BAR; PG8_SCHED;
            PG8_LDB(B0, 1, 0); PG8_LDB(B1, 1, 1); PG8_SCHED; PG8_LDA(At, 1, 0); PG8_STAGE(PG8_SA(0, 1), a2, v2[1]);
            PG8_WAIT_V(8); PG8_WAIT_L(0); PG8_BAR; PG8_MMA(0, 0, At, B0); PG8_MMA(0, 1, At, B1); PG8_BAR; PG8_SCHED;
            PG8_LDA(At, 1, 1); PG8_STAGE(PG8_SB(1, 0), b3, voffB); PG8_STAGE(PG8_SB(1, 1), b3 + hstep, voffB); PG8_STAGE(PG8_SA(1, 0), a3, v2[0]);
            PG8_WAIT_V(8); PG8_WAIT_L(0); PG8_BAR; PG8_MMA(1, 0, At, B0); PG8_MMA(1, 1, At, B1); PG8_BAR; PG8_SCHED;
            }
        }
        if constexpr (ALIGN_EPI) { if (wr == 0) PG8_BAR; }
        if constexpr (!Epi::AFTER_DRAIN) { E(acc, cur, wr, wc, fr, fq); S.done(cur); }
        if (!has_next) break;
#pragma unroll
        for (int a = 0; a < 2; ++a)
#pragma unroll
            for (int b = 0; b < 2; ++b)
#pragma unroll
                for (int m = 0; m < 4; ++m)
#pragma unroll
                    for (int n = 0; n < 2; ++n) acc[a][b][m][n] = (f32x4){0.f, 0.f, 0.f, 0.f};
        cur = nxt; cB = nB; ++ui;
#pragma unroll
        for (int h = 0; h < 2; ++h)
#pragma unroll
            for (int i = 0; i < 2; ++i) vc[h][i] = vn[h][i];
        if constexpr (ALIGN_EPI) { if (wr == 1) PG8_BAR; }
    }
    PG8_WAIT_V(0);
    if constexpr (!ALIGN_EPI) { if (wr == 0) PG8_BAR; }
    PG8_BAR;
    if constexpr (Epi::AFTER_DRAIN) { E.fused(acc, cur, wr, wc, fr, fq, lds, wid, lane); S.done(cur); }
#undef PG8_SA
#undef PG8_SB
#undef PG8_STAGE
#undef PG8_LDA
#undef PG8_LDB
#undef PG8_MMA
#undef PG8_WAIT_V
#undef PG8_WAIT_L
#undef PG8_BAR
#undef PG8_SCHED
}
}

constexpr int NWAVES = 8, NTHREADS = NWAVES * 64;
constexpr int RING_BYTES = 131072, LDSCTL_OFF = RING_BYTES, LDS_BYTES = 147456;
constexpr int CW_BAR = 4096;
static_assert((CW_BAR + XCD_BAR_WORDS) * 4 <= (int)MiB, "control words inside the memset region");
static_assert(SSM_LDS_BYTES <= RING_BYTES && (9 * 1024 + 21 * 24 * 9) * 4 <= RING_BYTES && NWAVES * 64 * 33 * 4 <= RING_BYTES, "LDS scratch fits the ring region");

__global__ void __launch_bounds__(NTHREADS, 2) mega(Ptrs P) {
    extern __shared__ __attribute__((aligned(16))) unsigned char lds[];
    const int G = gridDim.x; const int bx = blockIdx.x; const int vcu = (G % 8 == 0) ? (bx % 8) * (G / 8) + bx / 8 : bx;
    const int NGW = G * NWAVES;
#define IDS() int tid_ = threadIdx.x; asm volatile("" : "+v"(tid_)); const int tid = tid_, lane = tid & 63, wave = __builtin_amdgcn_readfirstlane(tid >> 6), gw = vcu * NWAVES + wave; (void)lane; (void)gw
    unsigned char* ws = P.ws;
    for (int u = threadIdx.x; u < (LDS_BYTES - LDSCTL_OFF) / 4; u += NTHREADS) ((unsigned*)(lds + LDSCTL_OFF))[u] = 0u;
    __syncthreads();
    XcdBarrier bar = xcd_barrier_post((unsigned*)(ws + WS_CTL) + CW_BAR, (volatile LAS unsigned*)(lds + LDSCTL_OFF));
#define GRID_BAR() xcd_barrier(bar)
    const float* mod = (const float*)(ws + WS_MOD);
    PG8_LAS unsigned char* ring = (PG8_LAS unsigned char*)lds;

    { IDS();
    for (int g = vcu; g < SG; g += G) ssm_tables_item(P, g, lds, tid, NTHREADS);
    for (int cb = vcu; cb < 256; cb += G) mod_cols(P, cb, (float*)lds, tid, NTHREADS);
    __syncthreads();
    for (int it = gw; it < IT_ALL; it += NGW) wprep_item(P, it, (float*)lds + wave * (64 * 33), lane);
    }
    GRID_BAR();
    { IDS();
    for (int r = gw; r < NROW; r += NGW) {
        const bool lat = r < NTOK; const int mr = lat ? r / SEQ : 8;
        const float* xrow = lat ? P.in[0] + (size_t)r * D : P.in[2] + (size_t)(r - NTOK) * D;
        norm_mod_row(xrow, P.in[6], mod + mr * 6144 + 1024, mod + mr * 6144 + 0, (bf16*)(ws + WS_H1) + (size_t)r * D, lane);
    }
    }
    GRID_BAR();
    { IDS();
    { pg8::Gemm g{(const bf16*)(ws + WS_H1), (const bf16*)(ws + WS_WIN_T), NROW, INC, D}; pg8::ProjOrder S; S.init(G, bx); pg8::EpiProj E{ws};
      pg8::gemm_phase<pg8::EpiProj, pg8::ProjOrder, true, true>(ring, g, S, E); }
    }
    GRID_BAR();
    { IDS();
    {
        const bf16* cbv = (const bf16*)(ws + WS_CBV); bf16* cbr = (bf16*)(ws + WS_CBR); const float* cw = P.in[19];
        const size_t total = (size_t)NTOK * 512;
        for (size_t i = (size_t)vcu * NTHREADS + tid; i < total; i += (size_t)G * NTHREADS) {
            const int tok = (int)(i / 512), j = (int)(i % 512), col = tok & 63;
            const bf16* r = cbv + (size_t)tok * 1536;
            float acc = cw[512 + j] * bf2f(r[512 + j]) * bf2f(r[1024 + j]);
            if (col > 0) acc += cw[j] * bf2f(r[512 + j - 1536]) * bf2f(r[1024 + j - 1536]);
            if (col < 63) acc += cw[1024 + j] * bf2f(r[512 + j + 1536]) * bf2f(r[1024 + j + 1536]);
            cbr[i] = (bf16)f2bf(bf2f(r[j]) * acc);
        }
        ngemm_dev<false>(FSloc{ws}, (const bf16*)(ws + WS_WINS), 256, (long)128 * 256, 256, 128, SG * 2 * NB, gw, NGW, lane);
    }
    }
    GRID_BAR();
    { IDS();
    for (int it = gw; it < SG * 2 * NB; it += NGW) {
        const int p = lane, b = it % 8, d = (it / 8) % 2, g = it / 16;
        const float* a16 = (const float*)(ws + WS_A16); const float ar = a16[((g * 2 + d) * 64 + p) * 2], ai = a16[((g * 2 + d) * 64 + p) * 2 + 1];
        const float* sl = (const float*)(ws + WS_SLOC) + (size_t)((g * 2 + d) * 8 + b) * NCHT * 128;
        bf16* ag = (bf16*)(ws + WS_AG) + ((size_t)g * 1024 + b * NCH) * 512 + 256 + d * 128;
        float sr = 0.f, si = 0.f;
        for (int kk = 0; kk < NCHC; ++kk) { const int k = d == 0 ? kk : NCHC - 1 - kk; const float lr = sl[k * 128 + p], li = sl[k * 128 + 64 + p];
            const float nr = ar * sr - ai * si + lr, ni = ar * si + ai * sr + li; sr = nr; si = ni; }
        for (int kk = 0; kk < NCH; ++kk) { const int k = d == 0 ? kk : NCH - 1 - kk;
            ag[(size_t)k * 512 + p] = (bf16)f2bf(sr); ag[(size_t)k * 512 + 64 + p] = (bf16)f2bf(si);
            const float lr = sl[(NCHC + k) * 128 + p], li = sl[(NCHC + k) * 128 + 64 + p];
            const float nr = ar * sr - ai * si + lr, ni = ar * si + ai * sr + li; sr = nr; si = ni; }
    }
    }
    GRID_BAR();
    { IDS();
    { pg8::Gemm g{(const bf16*)(ws + WS_AG), (const bf16*)(ws + WS_MG), SG * 1024, SG * 256, 512}; pg8::SsmOrder S{G, bx}; pg8::EpiSsmOut E{ws};
      pg8::gemm_phase<pg8::EpiSsmOut, pg8::SsmOrder, true, true>(ring, g, S, E); }
    }
    GRID_BAR();
    { IDS();
    { pg8::Gemm g{(const bf16*)(ws + WS_YG), (const bf16*)(ws + WS_WGLU_T), NTOK, 1024, 512}; pg8::PlainOrder S; S.init(NTOK, 1024, G, bx); pg8::EpiGlu E{ws};
      pg8::gemm_phase<pg8::EpiGlu, pg8::PlainOrder, true, true>(ring, g, S, E); }
    }
    GRID_BAR();
    { IDS();
    { pg8::Gemm g{(const bf16*)(ws + WS_GLU), (const bf16*)(ws + WS_WSSM_T), NTOK, 1024, 512}; pg8::PlainOrder S; S.init(NTOK, 1024, G, bx); pg8::EpiMerge<0> E{ws};
      pg8::gemm_phase<pg8::EpiMerge<0>, pg8::PlainOrder, true, true>(ring, g, S, E); }
    { pg8::Gemm g{(const bf16*)(ws + WS_CBR), (const bf16*)(ws + WS_WCONV_T), NTOK, 1024, 512}; pg8::PlainOrder S; S.init(NTOK, 1024, G, bx); pg8::EpiMerge<1> E{ws};
      pg8::gemm_phase<pg8::EpiMerge<1>, pg8::PlainOrder, true, true>(ring, g, S, E); }
    }
    GRID_BAR();
    { IDS();
    { pg8::Gemm g{(const bf16*)(ws + WS_MERGED), (const bf16*)(ws + WS_WO_T), NTOK, 1024, 1024}; pg8::PlainOrder S; S.init(NTOK, 1024, G, bx); pg8::EpiWo E{ws, P.in[0]};
      pg8::gemm_phase<pg8::EpiWo, pg8::PlainOrder, true, true>(ring, g, S, E); }
    }
    GRID_BAR();
    { IDS();
    for (int r = gw; r < NTOK; r += NGW) { const int b = r / SEQ;
        norm_mod_row((const float*)(ws + WS_XL1) + (size_t)r * D, P.in[7], mod + b * 6144 + 4096, mod + b * 6144 + 3072, (bf16*)(ws + WS_H2) + (size_t)r * D, lane); }
    }
    GRID_BAR();
    { IDS();
    { pg8::Gemm g{(const bf16*)(ws + WS_H2), (const bf16*)(ws + WS_WRS_T), NTOK, 768, 1024}; pg8::PlainOrder S; S.init(NTOK, 768, G, bx); pg8::EpiRS E{ws};
      pg8::gemm_phase<pg8::EpiRS, pg8::PlainOrder, true, true>(ring, g, S, E); }
    }
    GRID_BAR();
    { IDS();
    for (int tok = gw; tok < NTOK; tok += NGW) route_token(P, tok, lane);
    { pg8::Gemm g{(const bf16*)(ws + WS_HS), (const bf16*)(ws + WS_WSD_T), NTOK, 1024, 256}; pg8::PlainOrder S; S.init(NTOK, 1024, G, bx); pg8::EpiSharedDown E{ws};
      pg8::gemm_phase<pg8::EpiSharedDown, pg8::PlainOrder, true, true>(ring, g, S, E); }
    }
    GRID_BAR();
    PG8_LAS int* ts = (PG8_LAS int*)(lds + LDSCTL_OFF + 64);
    PG8_LAS unsigned* offs = (PG8_LAS unsigned*)(lds + LDSCTL_OFF + 2048);
    const unsigned* cntp = (const unsigned*)(ws + WS_CTL) + CW_CNT;
    { IDS();
    if (wave == 0) {
        int c4[4], s = 0;
#pragma unroll
        for (int i = 0; i < 4; ++i) { c4[i] = ((int)__hip_atomic_load(&cntp[lane * 4 + i], __ATOMIC_RELAXED, __HIP_MEMORY_SCOPE_AGENT) + 255) >> 8; s += c4[i]; }
        int incl = s;
#pragma unroll
        for (int o = 1; o < 64; o <<= 1) { const int v = __shfl_up(incl, o); if (lane >= o) incl += v; }
        int ex = incl - s;
#pragma unroll
        for (int i = 0; i < 4; ++i) { ts[lane * 4 + i] = ex; ex += c4[i]; }
        if (lane == 63) ts[256] = incl;
    }
    __syncthreads();
    {
        pg8::MoeOrder S; S.init(2, G, bx, ts, cntp);
        for (int i = 0; i < 12; ++i) { pg8::Unit u; if (!S.next(i, u)) break;
            if (tid < 256) { const int idx = u.mi * 256 + tid; const int tok = idx < u.cnt ? (((const int*)(ws + WS_LIST))[(size_t)u.e * LIST_CAP + idx] >> 3) : 0; offs[i * 256 + tid] = (unsigned)tok * (unsigned)(D * 2); } }
        __syncthreads();
        pg8::Gemm g{(const bf16*)(ws + WS_H2), (const bf16*)(ws + WS_WGU_T), NTOK, NE * 512, 1024}; pg8::EpiMoe1 E{ws}; pg8::LdsGather GA{offs};
        pg8::gemm_phase_gather<pg8::EpiMoe1, pg8::MoeOrder, pg8::LdsGather, true>(ring, g, S, E, GA);
    }
    }
    GRID_BAR();
    { IDS();
    { pg8::MoeOrder S; S.init(4, G, bx, ts, cntp); pg8::Gemm g{(const bf16*)(ws + WS_HBUF), (const bf16*)(ws + WS_WD_T), HB_ROWS, NE * 1024, 256}; pg8::EpiMoe2 E{ws};
      pg8::gemm_phase<pg8::EpiMoe2, pg8::MoeOrder, true, true>(ring, g, S, E); }
    }
    GRID_BAR();
    { IDS();
    for (int r = gw; r < NTOK; r += NGW) { const int b = r / SEQ;
        const f32x4* xr = (const f32x4*)((const float*)(ws + WS_XL1) + (size_t)r * D) + lane; f32x4 v[4]; float s = 0.f;
#pragma unroll
        for (int j = 0; j < 4; ++j) { f32x4 acc = (f32x4){0.f, 0.f, 0.f, 0.f};
            for (int k = 0; k < 8; ++k) { const u32x2 y = ((const u32x2*)((const bf16*)(ws + WS_YSLOT) + (size_t)(r * 8 + k) * D))[lane + 64 * j];
                acc.x += bf2f(y.x); acc.y += bf2f(y.x >> 16); acc.z += bf2f(y.y); acc.w += bf2f(y.y >> 16); }
            const f32x4 g2 = ((const f32x4*)(mod + b * 6144 + 5120))[lane + 64 * j];
            v[j] = xr[64 * j] + g2 * acc; s += (v[j].x * v[j].x + v[j].y * v[j].y) + (v[j].z * v[j].z + v[j].w * v[j].w); }
        const float rr = rsqrtf(wave_sum(s) * (1.f / D) + EPS);
        f32x4* o = (f32x4*)(P.out + (size_t)r * D) + lane;
#pragma unroll
        for (int j = 0; j < 4; ++j) { const f32x4 fg = ((const f32x4*)P.in[30])[lane + 64 * j]; o[64 * j] = v[j] * rr * fg; }
    }
    }
#undef GRID_BAR
}

extern "C" void kernel_launch(void* const* d_in, const int* in_sizes, int n_in, void* d_out, int out_size, void* d_ws, size_t ws_size, hipStream_t stream) {
    static int grid = 0;
    if (grid == 0) {
        if (n_in != 31 || out_size != NTOK * D || ws_size < WS_END) { fprintf(stderr, "kernel_launch: unexpected problem (n_in %d, out %d, ws %zu)\n", n_in, out_size, ws_size); grid = -1; return; }
        int dev = 0, cus = 0, per_cu = 0;
        if (hipGetDevice(&dev) != hipSuccess || hipDeviceGetAttribute(&cus, hipDeviceAttributeMultiprocessorCount, dev) != hipSuccess) { grid = -1; return; }
        if (hipFuncSetAttribute((const void*)mega, hipFuncAttributeMaxDynamicSharedMemorySize, LDS_BYTES) != hipSuccess) { fprintf(stderr, "kernel_launch: hipFuncSetAttribute failed\n"); grid = -1; return; }
        if (hipOccupancyMaxActiveBlocksPerMultiprocessor(&per_cu, (const void*)mega, NTHREADS, LDS_BYTES) != hipSuccess || per_cu < 1) { fprintf(stderr, "kernel_launch: occupancy query says %d blocks per CU\n", per_cu); (void)hipGetLastError(); grid = -1; return; }
        grid = cus;
    }
    if (grid < 0) return;
    Ptrs P{};
    for (int i = 0; i < 31; ++i) P.in[i] = (const float*)d_in[i];
    P.out = (float*)d_out; P.ws = (unsigned char*)d_ws;
    (void)hipMemsetAsync((char*)d_ws + WS_CTL, 0, MiB, stream);
    hipLaunchKernelGGL(mega, dim3(grid), dim3(NTHREADS), LDS_BYTES, stream, P);
}
```

```cpp
#include <hip/hip_runtime.h>
#include <cstdio>
#include <cstdint>

typedef unsigned short bf16;
typedef short bf16x8 __attribute__((ext_vector_type(8)));
typedef float f32x4 __attribute__((ext_vector_type(4)));
typedef unsigned u32x4 __attribute__((ext_vector_type(4)));
typedef unsigned u32x2 __attribute__((ext_vector_type(2)));

constexpr int D = 1024, NB = 8, SEQ = 2048, CTXL = 256;
constexpr int NTOK = NB * SEQ, NCTX = NB * CTXL, NROW = NTOK + NCTX;
constexpr int INC = 4096, SG = 32, SP = 64, SQ = 16, CT = 16;
constexpr int NCH = SEQ / CT, NCHC = CTXL / CT, NCHT = NCH + NCHC;
constexpr int NE = 256, TOPK = 8, ED = 256;
constexpr float EPS = 1e-6f;
constexpr int KSPLIT = 16;
constexpr int LIST_CAP = NTOK;
constexpr int HB_ROWS = NTOK * TOPK + NE * 256;

constexpr size_t MiB = 1u << 20;
constexpr size_t WS_CTL = 0;
constexpr size_t WS_MODP = 1 * MiB;
constexpr size_t WS_MOD = 5 * MiB;
constexpr size_t WS_A16 = 5 * MiB + 512 * 1024;
constexpr size_t WS_START = 5 * MiB + 600 * 1024;
constexpr size_t WS_WIN_T = 6 * MiB;
constexpr size_t WS_WGLU_T = 14 * MiB;
constexpr size_t WS_WSSM_T = 15 * MiB;
constexpr size_t WS_WCONV_T = 16 * MiB;
constexpr size_t WS_WO_T = 17 * MiB;
constexpr size_t WS_WRS_T = 19 * MiB;
constexpr size_t WS_WSD_T = 21 * MiB;
constexpr size_t WS_MG = 22 * MiB;
constexpr size_t WS_WGU_T = 34 * MiB;
constexpr size_t WS_WD_T = 290 * MiB;
constexpr size_t WS_H1 = 418 * MiB;
constexpr size_t WS_AG = 454 * MiB;
constexpr int AGR = 1280;
constexpr size_t WS_SLOC = 494 * MiB;
constexpr size_t WS_CBV = 534 * MiB;
constexpr size_t WS_GATES = 582 * MiB;
constexpr size_t WS_CBR = 646 * MiB;
constexpr size_t WS_YG = 662 * MiB;
constexpr size_t WS_GLU = 678 * MiB;
constexpr size_t WS_MERGED = 694 * MiB;
constexpr size_t WS_YSLOT = 418 * MiB;
constexpr size_t WS_XL1 = 726 * MiB;
constexpr size_t WS_H2 = 790 * MiB;
constexpr size_t WS_SCORES = 822 * MiB;
constexpr size_t WS_HS = 838 * MiB;
constexpr size_t WS_TW = 846 * MiB;
constexpr size_t WS_LIST = 848 * MiB;
constexpr size_t WS_HBUF = 864 * MiB;
constexpr size_t WS_YS9 = 960 * MiB;
constexpr size_t WS_WINS = 992 * MiB;
constexpr size_t WS_END = 1000 * MiB;
constexpr int CW_CNT = 16384, CNT_STRIDE = 32;

__device__ __forceinline__ unsigned f2bf(float f) { unsigned u = __builtin_bit_cast(unsigned, f); return (u + 0x7fffu + ((u >> 16) & 1u)) >> 16; }
__device__ __forceinline__ unsigned pk2(float lo, float hi) { return f2bf(lo) | (f2bf(hi) << 16); }
__device__ __forceinline__ float bf2f(unsigned h) { return __builtin_bit_cast(float, (h & 0xffffu) << 16); }
__device__ __forceinline__ float sigmoidf_(float v) { return 1.0f / (1.0f + __expf(-v)); }
__device__ __forceinline__ float siluf_(float v) { return v / (1.0f + __expf(-v)); }
__device__ __forceinline__ float gelu_tanh(float v) { const float u = 0.7978845608028654f * (v + 0.044715f * v * v * v); return 0.5f * v * (1.0f + tanhf(u)); }
__device__ __forceinline__ float wave_sum(float v) {
#pragma unroll
    for (int o = 1; o < 64; o <<= 1) v += __shfl_xor(v, o);
    return v;
}

struct Ptrs {
    const float* in[31];
    float* out;
    unsigned char* ws;
};

__device__ __forceinline__ void mod_cols(const Ptrs& P, int cb, float* sil, int t, int nt) {
    float* part = sil + 9 * 1024;
    const float* c = P.in[1]; const float* cc = P.in[3]; const float* wm = P.in[4]; const float* bm = P.in[5];
    __syncthreads();
    for (int i = t; i < 9 * 1024; i += nt) { const int r = i >> 10, k = i & 1023; const float v = r < 8 ? c[r * D + k] : cc[k]; sil[i] = siluf_(v); }
    __syncthreads();
    if (t < 504) { const int col = t % 24, ks = t / 24; const int k0 = ks * 49, k1 = (k0 + 49 < 1024) ? k0 + 49 : 1024;
        float acc[9];
#pragma unroll
        for (int r = 0; r < 9; ++r) acc[r] = 0.f;
#pragma unroll 7
        for (int k = k0; k < k1; ++k) { const float w = wm[(size_t)k * 6144 + cb * 24 + col];
#pragma unroll
            for (int r = 0; r < 9; ++r) acc[r] += sil[r * 1024 + k] * w; }
#pragma unroll
        for (int r = 0; r < 9; ++r) part[(ks * 24 + col) * 9 + r] = acc[r]; }
    __syncthreads();
    if (t < 216) { const int r = t / 24, col = t % 24; float s = bm[cb * 24 + col];
        for (int ks = 0; ks < 21; ++ks) s += part[(ks * 24 + col) * 9 + r];
        ((float*)(P.ws + WS_MOD))[r * 6144 + cb * 24 + col] = s; }
    __syncthreads();
}

__device__ __forceinline__ void transpose_item(const float* W, int ldw, bf16* WT, int ldt, int k0, int n0, int dst_row0, float* scr, int lane) {
#pragma unroll 8
    for (int i = 0; i < 32; ++i) { const int kk = 2 * i + (lane >> 5); scr[kk * 33 + (lane & 31)] = W[(size_t)(k0 + kk) * ldw + n0 + (lane & 31)]; }
    asm volatile("s_waitcnt lgkmcnt(0)" ::: "memory");
    const int c = lane & 7;
#pragma unroll
    for (int j = 0; j < 4; ++j) { const int n = (lane >> 3) + 8 * j; const float* s = scr + (8 * c) * 33 + n;
        u32x4 o; o.x = pk2(s[0 * 33], s[1 * 33]); o.y = pk2(s[2 * 33], s[3 * 33]); o.z = pk2(s[4 * 33], s[5 * 33]); o.w = pk2(s[6 * 33], s[7 * 33]);
        *(u32x4*)(WT + (size_t)(dst_row0 + n) * ldt + k0 + 8 * c) = o; }
    asm volatile("s_waitcnt lgkmcnt(0)" ::: "memory");
}
template <int KIND>
__device__ __forceinline__ void wprep_loop(const float* W, int ldw, bf16* WT, int ldt, int nkb, int nnb, int roff, int nbatch, size_t wstride, size_t tstride, float* scr, int lane, int gw_in, int NGW, int woff) {
    const int per = nkb * nnb, total = nbatch * per; const int gw = (gw_in + NGW - (woff % NGW)) % NGW;
    for (int it = gw; it < total; it += NGW) { const int e = it / per, r = it % per, nb = r % nnb, kb = r / nnb, n0 = nb * 32;
        const int dst = roff + (KIND == 0 ? n0 : KIND == 1 ? 256 * ((n0 % 512) / 128) + (n0 / 512) * 128 + (n0 % 128) : 256 * (n0 / 128) + (n0 % 128));
        transpose_item(W + (size_t)e * wstride, ldw, WT + (size_t)e * tstride, ldt, kb * 64, n0, dst, scr, lane); }
}

__device__ __forceinline__ const float* xp_src(const float* wg, const float* wu, const float* wd, int T, int& ldw) {
    const int kind = T / (NE * 16), e = (T >> 4) & (NE - 1), t = T & 15;
    if (kind == 2) { ldw = 1024; return wd + (size_t)e * 256 * 1024 + (size_t)((t >> 2) * 64) * 1024 + (t & 3) * 256; }
    ldw = 256; return (kind == 0 ? wg : wu) + (size_t)e * 1024 * 256 + (size_t)(t * 64) * 256;
}
__device__ __forceinline__ void xpose_experts(const float* wg, const float* wu, const float* wd, bf16* wgu_t, bf16* wd_t, float* s, int tid_in, int c, int G) {
    int tid = tid_in; asm volatile("" : "+v"(tid));
    const int lane = tid & 63, wave = tid >> 6, cc = tid & 7, nn = tid >> 3;
    const int NT = 3 * NE * 16;
    f32x4 v[8]; int ldw = 256;
    if (c < NT) { const float* w0 = xp_src(wg, wu, wd, c, ldw);
#pragma unroll
        for (int i = 0; i < 8; ++i) v[i] = *(const f32x4*)(w0 + (unsigned)((wave + 8 * i) * ldw + 4 * lane)); }
#pragma unroll 1
    for (int T = c; T < NT; T += G) {
        { float* d = s + wave * 257 + 4 * lane;
#pragma unroll
          for (int i = 0; i < 8; ++i) { d[i * 8 * 257 + 0] = v[i][0]; d[i * 8 * 257 + 1] = v[i][1]; d[i * 8 * 257 + 2] = v[i][2]; d[i * 8 * 257 + 3] = v[i][3]; } }
        if (T + G < NT) { int l2; const float* w1 = xp_src(wg, wu, wd, T + G, l2);
#pragma unroll
            for (int i = 0; i < 8; ++i) v[i] = *(const f32x4*)(w1 + (unsigned)((wave + 8 * i) * l2 + 4 * lane)); }
        __syncthreads();
        { const int kind = T / (NE * 16), e = (T >> 4) & (NE - 1), t = T & 15;
          const float* q = s + (8 * cc) * 257 + nn;
          bf16* wt; int ldt, k0, n0, roff;
          if (kind == 2) { wt = wd_t + (size_t)e * 1024 * 256; ldt = 256; k0 = (t >> 2) * 64; n0 = (t & 3) * 256; roff = 0; }
          else { wt = wgu_t + (size_t)e * 512 * 1024; ldt = 1024; k0 = t * 64; n0 = 0; roff = kind * 128; }
          wt += k0 + 8 * cc;
#pragma unroll
          for (int j = 0; j < 4; ++j) { const float* qq = q + 64 * j;
            u32x4 o; o.x = pk2(qq[0], qq[257]); o.y = pk2(qq[2 * 257], qq[3 * 257]); o.z = pk2(qq[4 * 257], qq[5 * 257]); o.w = pk2(qq[6 * 257], qq[7 * 257]);
            const int ng = n0 + nn + 64 * j, dr = kind == 2 ? ng : roff + 256 * (ng / 128) + (ng % 128);
            *(u32x4*)(wt + (unsigned)(dr * ldt)) = o; } }
        __syncthreads();
    }
}

constexpr int SSM_LDS_BYTES = 2 * 64 * 17 * 8 + 2 * 64 * 16 * 8 + 2 * 16 * 64 * 8 + 2 * 16 * 256 * 4;
__device__ __forceinline__ void ssm_tables_item(const Ptrs& P, int g, unsigned char* lds, int t, int nt) {
    float2* apw = (float2*)lds; float2* bb = apw + 2 * 64 * 17; float2* cc = bb + 2 * 64 * 16; float* kt = (float*)(cc + 2 * 16 * 64);
    const float *lre = P.in[9], *lim = P.in[10], *ldt = P.in[11], *bre = P.in[12], *bim = P.in[13], *cre = P.in[14], *cim = P.in[15], *dv = P.in[16];
    __syncthreads();
    for (int i = t; i < 2 * 64; i += nt) { const int d = i / 64, p = i % 64;
        const float dt = expf(ldt[d * SG + g]); const float lr = lre[(d * SG + g) * SP + p], li = lim[(d * SG + g) * SP + p];
        for (int n = 0; n <= 16; ++n) { const float mag = expf(lr * dt * (float)n); float ang = li * dt * (float)n; ang -= 6.2831853071795865f * rintf(ang * 0.15915494309189535f);
            apw[(d * 64 + p) * 17 + n] = make_float2(mag * cosf(ang), mag * sinf(ang)); }
        const float ar = apw[(d * 64 + p) * 17 + 1].x, ai = apw[(d * 64 + p) * 17 + 1].y;
        const float den = lr * lr + li * li; const float kr = ((ar - 1.0f) * lr + ai * li) / den, ki = (ai * lr - (ar - 1.0f) * li) / den;
        for (int c = 0; c < 16; ++c) { const float br = bre[((d * SG + g) * SP + p) * SQ + c], bi = bim[((d * SG + g) * SP + p) * SQ + c];
            bb[(d * 64 + p) * 16 + c] = make_float2(kr * br - ki * bi, kr * bi + ki * br); }
        float* a16 = (float*)(P.ws + WS_A16); a16[((g * 2 + d) * 64 + p) * 2 + 0] = apw[(d * 64 + p) * 17 + 16].x; a16[((g * 2 + d) * 64 + p) * 2 + 1] = apw[(d * 64 + p) * 17 + 16].y;
    }
    for (int i = t; i < 2 * 16 * 64; i += nt) { const int d = i / 1024, c = (i / 64) % 16, p = i % 64;
        cc[i] = make_float2(cre[((d * SG + g) * SQ + c) * SP + p], cim[((d * SG + g) * SQ + c) * SP + p]); }
    __syncthreads();
    for (int i = t; i < 2 * 16 * 256; i += nt) { const int d = i / 4096, tau = (i / 256) % 16, c = (i / 16) % 16, c2 = i % 16; float s = 0.f;
        for (int p = 0; p < 64; ++p) { const float2 C = cc[(d * 16 + c) * 64 + p], A = apw[(d * 64 + p) * 17 + tau], B = bb[(d * 64 + p) * 16 + c2];
            const float abr = A.x * B.x - A.y * B.y, abi = A.x * B.y + A.y * B.x; s += C.x * abr - C.y * abi; }
        kt[i] = s; }
    __syncthreads();
    bf16* mg = (bf16*)(P.ws + WS_MG) + (size_t)g * 256 * 512;
    for (int i = t; i < 256 * 64; i += nt) { const int n = i >> 6, k0 = (i & 63) * 8, tt = n >> 4, c = n & 15; float v[8];
        if (k0 < 256) { const int s = k0 >> 4, c20 = k0 & 15;
#pragma unroll
            for (int j = 0; j < 8; ++j) { const int c2 = c20 + j;
                if (tt > s) v[j] = kt[(tt - s) * 256 + c * 16 + c2];
                else if (tt < s) v[j] = kt[(16 + (s - tt)) * 256 + c * 16 + c2];
                else v[j] = kt[c * 16 + c2] + kt[16 * 256 + c * 16 + c2] + (c == c2 ? dv[g * 16 + c] : 0.f); }
        } else { const int kk = k0 - 256, d = kk >> 7, part = (kk >> 6) & 1, p0 = kk & 63;
#pragma unroll
            for (int j = 0; j < 8; ++j) { const int p = p0 + j; const float2 C = cc[(d * 16 + c) * 64 + p], A = apw[(d * 64 + p) * 17 + (d == 0 ? tt + 1 : 16 - tt)];
                v[j] = part == 0 ? (C.x * A.x - C.y * A.y) : -(C.x * A.y + C.y * A.x); } }
        u32x4 o; o.x = pk2(v[0], v[1]); o.y = pk2(v[2], v[3]); o.z = pk2(v[4], v[5]); o.w = pk2(v[6], v[7]);
        *(u32x4*)(mg + (size_t)n * 512 + k0) = o; }
    bf16* wi = (bf16*)(P.ws + WS_WINS) + (size_t)g * 256 * 512;
    for (int i = t; i < 256 * 64; i += nt) { const int row = i >> 6, k0 = (i & 63) * 8, d = row >> 7, n = row & 127, p = n & 63; float v[8];
        if (k0 < 256) { const int s = k0 >> 4, c20 = k0 & 15; const float2 A = apw[(d * 64 + p) * 17 + (d == 0 ? 15 - s : s)];
#pragma unroll
            for (int j = 0; j < 8; ++j) { const float2 B = bb[(d * 64 + p) * 16 + c20 + j]; v[j] = n < 64 ? (A.x * B.x - A.y * B.y) : (A.x * B.y + A.y * B.x); }
        } else {
#pragma unroll
            for (int j = 0; j < 8; ++j) v[j] = 0.f; }
        u32x4 o; o.x = pk2(v[0], v[1]); o.y = pk2(v[2], v[3]); o.z = pk2(v[4], v[5]); o.w = pk2(v[6], v[7]);
        *(u32x4*)(wi + (size_t)row * 512 + k0) = o; }
}

__device__ __forceinline__ void norm_mod_row(const float* xrow, const float* gam, const float* sc, const float* sh, bf16* orow, int lane) {
    const f32x4* xr = (const f32x4*)xrow + lane; f32x4 v[4]; float s = 0.f;
#pragma unroll
    for (int j = 0; j < 4; ++j) { v[j] = xr[64 * j]; s += (v[j].x * v[j].x + v[j].y * v[j].y) + (v[j].z * v[j].z + v[j].w * v[j].w); }
    const float r = rsqrtf(wave_sum(s) * (1.f / D) + EPS);
    unsigned long long* o8 = (unsigned long long*)orow + lane;
#pragma unroll
    for (int j = 0; j < 4; ++j) { const f32x4 g4 = ((const f32x4*)gam)[lane + 64 * j], s4 = ((const f32x4*)sc)[lane + 64 * j], h4 = ((const f32x4*)sh)[lane + 64 * j];
        const float a = v[j].x * r * g4.x * (1.f + s4.x) + h4.x, b = v[j].y * r * g4.y * (1.f + s4.y) + h4.y, c = v[j].z * r * g4.z * (1.f + s4.z) + h4.z, d = v[j].w * r * g4.w * (1.f + s4.w) + h4.w;
        o8[64 * j] = (unsigned long long)pk2(a, b) | ((unsigned long long)pk2(c, d) << 32); }
}

__device__ __forceinline__ void route_token(const Ptrs& P, int tok, int lane) {
    const f32x4 sc = ((const f32x4*)((const float*)(P.ws + WS_SCORES) + (size_t)tok * 256))[lane];
    const f32x4 bi = ((const f32x4*)P.in[23])[lane];
    float c0 = sc.x + bi.x, c1 = sc.y + bi.y, c2 = sc.z + bi.z, c3 = sc.w + bi.w;
    float t1 = fmaxf(c0, c1), t2 = fminf(c0, c1);
    { const float a = fmaxf(c2, c3), b = fminf(c2, c3); const float n1 = fmaxf(t1, a); const float n2 = fmaxf(fminf(t1, a), fmaxf(t2, b)); t1 = n1; t2 = n2; }
#pragma unroll
    for (int o = 1; o < 8; o <<= 1) { const float a = __shfl_xor(t1, o), b = __shfl_xor(t2, o); const float n1 = fmaxf(t1, a); const float n2 = fmaxf(fminf(t1, a), fmaxf(t2, b)); t1 = n1; t2 = n2; }
    const float gs = t1 + t2; const int myg = lane >> 3; int rank = 0;
#pragma unroll
    for (int j = 0; j < 8; ++j) { const float o = __shfl(gs, j * 8); rank += (o > gs || (o == gs && j < myg)) ? 1 : 0; }
    if (rank >= 4) { c0 = c1 = c2 = c3 = -INFINITY; }
    int sel_e = 0; float sel_s = 0.f; float ssum = 0.f;
#pragma unroll
    for (int k = 0; k < 8; ++k) {
        float bv = c0, bs = sc.x; int be = lane * 4;
        if (c1 > bv) { bv = c1; bs = sc.y; be = lane * 4 + 1; }
        if (c2 > bv) { bv = c2; bs = sc.z; be = lane * 4 + 2; }
        if (c3 > bv) { bv = c3; bs = sc.w; be = lane * 4 + 3; }
#pragma unroll
        for (int o = 1; o < 64; o <<= 1) { const float ov = __shfl_xor(bv, o), os = __shfl_xor(bs, o); const int oe = __shfl_xor(be, o);
            if (ov > bv || (ov == bv && oe < be)) { bv = ov; bs = os; be = oe; } }
        if (lane == k) { sel_e = be; sel_s = bs; }
        ssum += bs;
        if ((be >> 2) == lane) { const int q = be & 3; if (q == 0) c0 = -INFINITY; else if (q == 1) c1 = -INFINITY; else if (q == 2) c2 = -INFINITY; else c3 = -INFINITY; }
    }
    if (lane < 8) {
        const float w = sel_s / ssum * 2.5f;
        unsigned* cnt = (unsigned*)(P.ws + WS_CTL) + CW_CNT;
        const unsigned rk = atomicAdd(&cnt[sel_e * CNT_STRIDE], 1u);
        ((int*)(P.ws + WS_LIST))[(size_t)sel_e * LIST_CAP + rk] = tok * 8 + lane;
        ((float*)(P.ws + WS_TW))[tok * 8 + lane] = w;
    }
}
#define XB_TMO      128
#define XB_XCNT(j)  (256  + 64 * (j))
#define XB_XSUB(j)  (1280 + 64 * (j))
#define XB_XGEN(j)  (2304 + 64 * (j))
#define XB_TOP      3328
#define XB_TOPGEN   3392
#define XCD_BAR_WORDS 3456
#define XB_SPIN_CAP (1u << 18)
#define LAS __attribute__((address_space(3)))

__device__ __forceinline__ unsigned xb_ld(unsigned* p)              { return __hip_atomic_load(p, __ATOMIC_RELAXED, __HIP_MEMORY_SCOPE_AGENT); }
__device__ __forceinline__ unsigned xb_add(unsigned* p, unsigned v) { return __hip_atomic_fetch_add(p, v, __ATOMIC_RELAXED, __HIP_MEMORY_SCOPE_AGENT); }
__device__ __forceinline__ unsigned xb_xcc_id() { return (unsigned)__builtin_amdgcn_s_getreg((3 << 11) | 20) & 0xFu; }
#define XB_SPIN(cond, bar) do { unsigned _sp = 0; while (cond) { __builtin_amdgcn_s_sleep(1); \
    if ((++_sp & 255u) == 0u) { if (xb_ld(&(bar)[XB_TMO])) break; if (_sp > XB_SPIN_CAP) { atomicAdd(&(bar)[XB_TMO], 1u); break; } } } } while (0)

struct XcdBarrier {
    unsigned* bar; unsigned x;
    volatile LAS unsigned* st;
};

__device__ __forceinline__ XcdBarrier xcd_barrier_post(unsigned* bar, volatile LAS unsigned* st, int tid) {
    XcdBarrier b; b.bar = bar; b.x = xb_xcc_id(); b.st = st;
    if (tid == 0) (void)xb_add(&bar[XB_XCNT(b.x)], 1u);
    return b;
}
__device__ __forceinline__ void xcd_barrier_complete(unsigned* bar, unsigned x, unsigned& nloc, unsigned& nx) {
    const unsigned G = gridDim.x * gridDim.y * gridDim.z;
    unsigned sum, cnt, mine, sp = 0u;
    for (;;) {
        sum = 0u; cnt = 0u; mine = 0u;
#pragma unroll 1
        for (unsigned j = 0; j < 16; ++j) { const unsigned c = xb_ld(&bar[XB_XCNT(j)]); sum += c; cnt += (c > 0u) ? 1u : 0u; mine = (j == x) ? c : mine; }
        if (sum == G) break;
        __builtin_amdgcn_s_sleep(1);
        if ((++sp & 255u) == 0u) { if (xb_ld(&bar[XB_TMO])) break; if (sp > XB_SPIN_CAP) { atomicAdd(&bar[XB_TMO], 1u); break; } }
    }
    nloc = mine > 0u ? mine : 1u; nx = cnt > 0u ? cnt : 1u;
}

__device__ __forceinline__ void xcd_barrier(const XcdBarrier& b, int tid) {
    asm volatile("s_waitcnt vmcnt(0)" ::: "memory");
    __syncthreads();
    if (tid == 0) {
        unsigned* bar = b.bar;
        __builtin_amdgcn_s_waitcnt(0);
        unsigned nloc = b.st[0], nx = b.st[1];
        if (nloc == 0u) { xcd_barrier_complete(bar, b.x, nloc, nx); b.st[0] = nloc; b.st[1] = nx; }
        const unsigned old = xb_add(&bar[XB_XSUB(b.x)], 1u);
        const unsigned gen = old / nloc;
        if (old + 1u == (gen + 1u) * nloc) {
            __builtin_amdgcn_fence(__ATOMIC_RELEASE, "agent");
            asm volatile("s_waitcnt vmcnt(0)" ::: "memory");
            const unsigned og = xb_add(&bar[XB_TOP], 1u);
            const unsigned tg = og / nx;
            if (og + 1u == (tg + 1u) * nx) xb_add(&bar[XB_TOPGEN], 1u);
            else XB_SPIN(xb_ld(&bar[XB_TOPGEN]) == tg, bar);
            __builtin_amdgcn_fence(__ATOMIC_ACQUIRE, "agent");
            xb_add(&bar[XB_XGEN(b.x)], 1u);
            asm volatile("s_waitcnt vmcnt(0)" ::: "memory");
        } else {
            XB_SPIN(xb_ld(&bar[XB_XGEN(b.x)]) == gen, bar);
            __builtin_amdgcn_fence(__ATOMIC_ACQUIRE, "agent");
            asm volatile("s_waitcnt vmcnt(0)" ::: "memory");
        }
    }
    __syncthreads();
}

namespace pg8 {
#define PG8_LAS __attribute__((address_space(3)))
typedef unsigned short bf16_t;
typedef short bf16x8 __attribute__((ext_vector_type(8)));
typedef float f32x4 __attribute__((ext_vector_type(4)));
typedef unsigned u32x4 __attribute__((ext_vector_type(4)));
constexpr int BM = 256, BK = 64, HALF = 128, HTB = HALF * BK * 2  , STAGE_BYTES = 8 * HTB, NXCD = 8, WGM = 8;

__host__ __device__ __forceinline__ int lds_byte(int r, int c) { const int st = (r >> 4) * 2 + (c >> 5), rr = r & 15, cc = c & 31, ob = rr * 64 + cc * 2; return st * 1024 + (ob ^ (((ob >> 9) & 1) << 5)); }
__host__ __device__ __forceinline__ void stage_rc(int b, int& R, int& C) { const int st = b / 1024, sb = b % 1024, swz = sb ^ (((sb >> 9) & 1) << 5); R = (st >> 1) * 16 + swz / 64; C = (st & 1) * 32 + (swz % 64) / 2; }
__host__ __device__ __forceinline__ int perm32(int rho) { const int n = rho >> 4, i = rho & 15; return 8 * (i >> 2) + 4 * n + (i & 3); }

struct Unit { int pm, pn, e, mi, cnt, ord; };
struct Gemm { const bf16_t* A; const bf16_t* Bt; int M, N, K; };

struct StaticOrder {
    int nM, nN, nwg, G, c;
    __host__ __device__ __forceinline__ void init(int M, int N, int G_, int c_) { nM = M / BM; nN = N / BM; nwg = nM * nN; G = G_; c = c_; }
    __host__ __device__ __forceinline__ bool next(int i, Unit& u) const {
        const long L = (long)i * G + c; if (L >= nwg) return false;
        int wgid = (int)L; { const int q = nwg / NXCD, r = nwg % NXCD, xcd = wgid % NXCD, off = wgid / NXCD; wgid = (xcd < r ? xcd * (q + 1) : r * (q + 1) + (xcd - r) * q) + off; }
        const int nig = WGM * nN, gid = wgid / nig, fm = gid * WGM, gsz = (nM - fm) < WGM ? (nM - fm) : WGM;
        u.pm = fm + ((wgid % nig) % gsz); u.pn = (wgid % nig) / gsz; return true;
    }
    __device__ __forceinline__ void a_ready(const Unit&) const {}
    __device__ __forceinline__ void done(const Unit&) const {}
};

__device__ __forceinline__ unsigned cvt_pk_bf16(float lo, float hi) { unsigned r; asm volatile("v_cvt_pk_bf16_f32 %0, %1, %2" : "=v"(r) : "v"(lo), "v"(hi)); return r; }
__device__ __forceinline__ float sigm(float v) { return 1.0f / (1.0f + __expf(-v)); }
__device__ __forceinline__ u32x4 pack8(const f32x4 a, const f32x4 b) { u32x4 w; w.x = cvt_pk_bf16(a[0], a[1]); w.y = cvt_pk_bf16(a[2], a[3]); w.z = cvt_pk_bf16(b[0], b[1]); w.w = cvt_pk_bf16(b[2], b[3]); return w; }
__device__ __forceinline__ float bfl(unsigned w) { return __builtin_bit_cast(float, w << 16); }
__device__ __forceinline__ float bfh(unsigned w) { return __builtin_bit_cast(float, w & 0xffff0000u); }

struct ProjOrder {
    StaticOrder so; int G, c;
    __device__ __forceinline__ void init(int G_, int c_) { so.init(NTOK, INC, G_, c_); G = G_; c = c_; }
    __device__ __forceinline__ bool next(int i, Unit& u) const { u.e = 0; u.mi = 0; u.cnt = 0; u.ord = i;
        if (so.next(i, u)) return true;
        const long L = (long)i * G + c - so.nwg; if (L < 0 || L >= 16) return false; u.pm = 64 + (int)(L >> 1); u.pn = (int)(L & 1); return true; }
    __device__ __forceinline__ void a_ready(const Unit&) const {}
    __device__ __forceinline__ void done(const Unit&) const {}
};
struct PlainOrder {
    StaticOrder so;
    __device__ __forceinline__ void init(int M, int N, int G_, int c_) { so.init(M, N, G_, c_); }
    __device__ __forceinline__ bool next(int i, Unit& u) const { u.e = 0; u.mi = 0; u.cnt = 0; u.ord = i; return so.next(i, u); }
    __device__ __forceinline__ void a_ready(const Unit&) const {}
    __device__ __forceinline__ void done(const Unit&) const {}
};
struct SsmOrder {
    int G, c, per;
    __device__ __forceinline__ bool next(int i, Unit& u) const { const long L = (long)i * G + c; if (L >= 32 * per) return false; const int g = (int)L / per, mi = (int)L % per;
        u.pm = g * 5 + mi; u.pn = g; u.e = g; u.mi = mi; u.cnt = 0; u.ord = i; return true; }
    __device__ __forceinline__ void a_ready(const Unit&) const {}
    __device__ __forceinline__ void done(const Unit&) const {}
};
struct MoeOrder {
    int nn, nwg, G, c; const PG8_LAS int* ts; const unsigned* cntp;
    __device__ __forceinline__ void init(int nn_, int G_, int c_, const PG8_LAS int* ts_, const unsigned* cnt_) { nn = nn_; G = G_; c = c_; ts = ts_; cntp = cnt_; nwg = ts_[256] * nn_; }
    __device__ __forceinline__ bool next(int i, Unit& u) const {
        const long L = (long)i * G + c; if (L >= nwg) return false;
        int wgid = (int)L; { const int q = nwg / NXCD, r = nwg % NXCD, xcd = wgid % NXCD, off = wgid / NXCD; wgid = (xcd < r ? xcd * (q + 1) : r * (q + 1) + (xcd - r) * q) + off; }
        const int T = wgid / nn, j = wgid % nn;
        int lo = 0, hi = 257;
#pragma unroll 1
        while (lo < hi) { const int mid = (lo + hi) >> 1; if (ts[mid] <= T) lo = mid + 1; else hi = mid; }
        const int e = __builtin_amdgcn_readfirstlane(lo - 1);
        u.e = e; u.mi = __builtin_amdgcn_readfirstlane(T - ts[e]); u.pm = __builtin_amdgcn_readfirstlane(T); u.pn = e * nn + j; u.ord = i;
        u.cnt = __builtin_amdgcn_readfirstlane((int)cntp[e * CNT_STRIDE]); return true; }
    __device__ __forceinline__ void a_ready(const Unit&) const {}
    __device__ __forceinline__ void done(const Unit&) const {}
};
struct TableOrder {
    const PG8_LAS int* ut; int n;
    __device__ __forceinline__ bool next(int i, Unit& u) const { if (i >= n) return false; const PG8_LAS int* r = ut + i * 8;
        u.pm = __builtin_amdgcn_readfirstlane(r[0]); u.pn = __builtin_amdgcn_readfirstlane(r[1]); u.e = __builtin_amdgcn_readfirstlane(r[2]);
        u.mi = __builtin_amdgcn_readfirstlane(r[3]); u.cnt = __builtin_amdgcn_readfirstlane(r[4]); u.ord = i; return true; }
    __device__ __forceinline__ void a_ready(const Unit&) const {}
    __device__ __forceinline__ void done(const Unit&) const {}
};
__device__ __forceinline__ int moe_unit_table(PG8_LAS int* ut, const PG8_LAS int* ts, const unsigned* cntp, int nn, int G, int c, int lane) {
    const int nwg = ts[256] * nn; const long L = (long)lane * G + c;
    if (lane < 16 && L < nwg) {
        int wgid = (int)L; { const int q = nwg / NXCD, r = nwg % NXCD, xcd = wgid % NXCD, off = wgid / NXCD; wgid = (xcd < r ? xcd * (q + 1) : r * (q + 1) + (xcd - r) * q) + off; }
        const int T = wgid / nn, j = wgid % nn; int lo = 0, hi = 257;
        while (lo < hi) { const int mid = (lo + hi) >> 1; if (ts[mid] <= T) lo = mid + 1; else hi = mid; }
        const int e = lo - 1; PG8_LAS int* r = ut + lane * 8;
        r[0] = T; r[1] = e * nn + j; r[2] = e; r[3] = T - ts[e]; r[4] = (int)__hip_atomic_load(&cntp[e * CNT_STRIDE], __ATOMIC_RELAXED, __HIP_MEMORY_SCOPE_AGENT);
    }
    int n = (nwg - c + G - 1) / G; if (n < 0) n = 0; if (n > 16) n = 16; return n;
}
struct LdsGather { const PG8_LAS unsigned* offs; __device__ __forceinline__ unsigned row_off(const Unit& u, int r) const { return offs[u.ord * 256 + r]; } };

struct EpiProj {
    static constexpr bool PERM = true, AFTER_DRAIN = false; unsigned char* ws;
    __device__ __forceinline__ void operator()(const f32x4 (&acc)[2][2][4][2], const Unit& u, int wr, int wc, int fr, int fq) const {
#pragma unroll
        for (int ai = 0; ai < 2; ++ai)
#pragma unroll
            for (int m = 0; m < 4; ++m) { const int row = u.pm * BM + ai * HALF + wr * 64 + m * 16 + fr;
#pragma unroll
                for (int bj = 0; bj < 2; ++bj) { const int col = u.pn * BM + bj * HALF + wc * 32 + 8 * fq; f32x4 v0 = acc[ai][bj][m][0], v1 = acc[ai][bj][m][1];
                    bf16_t* dst;
                    if (u.pn < 2) { const int g = col >> 4, c0 = col & 15;
                        if (u.pm < 64) { const int b = row >> 11, l = row & 2047; dst = (bf16_t*)(ws + WS_AG) + ((size_t)g * AGR + b * NCH + (l >> 4)) * 512 + (l & 15) * 16 + c0; }
                        else { const int r2 = row - NTOK, b = r2 >> 8, l = r2 & 255; dst = (bf16_t*)(ws + WS_AG) + ((size_t)g * AGR + 1024 + b * NCHC + (l >> 4)) * 512 + (l & 15) * 16 + c0; } }
                    else if (u.pn < 8) dst = (bf16_t*)(ws + WS_CBV) + (size_t)row * 1536 + (col - 512);
                    else { dst = (bf16_t*)(ws + WS_GATES) + (size_t)row * 2048 + (col - 2048);
#pragma unroll
                        for (int q = 0; q < 4; ++q) { v0[q] = sigm(v0[q]); v1[q] = sigm(v1[q]); } }
                    *(u32x4*)dst = pack8(v0, v1); } }
    }
};
struct EpiSsmOut {
    static constexpr bool PERM = true, AFTER_DRAIN = false; unsigned char* ws;
    __device__ __forceinline__ void operator()(const f32x4 (&acc)[2][2][4][2], const Unit& u, int wr, int wc, int fr, int fq) const {
        const int g = u.pn;
#pragma unroll
        for (int ai = 0; ai < 2; ++ai)
#pragma unroll
            for (int m = 0; m < 4; ++m) { const int rl = u.mi * BM + ai * HALF + wr * 64 + m * 16 + fr; const int b = rl >> 7, ch = rl & 127;
#pragma unroll
                for (int bj = 0; bj < 2; ++bj) { const int nc = bj * HALF + wc * 32 + 8 * fq, tt = nc >> 4, c0 = nc & 15; f32x4 v0 = acc[ai][bj][m][0], v1 = acc[ai][bj][m][1];
#pragma unroll
                    for (int q = 0; q < 4; ++q) { const float a = v0[q], bq = v1[q];
                        v0[q] = a * sigm(1.5957691216057308f * (a + 0.044715f * a * a * a)); v1[q] = bq * sigm(1.5957691216057308f * (bq + 0.044715f * bq * bq * bq)); }
                    *(u32x4*)((bf16_t*)(ws + WS_YG) + ((size_t)b * SEQ + ch * CT + tt) * 512 + g * 16 + c0) = pack8(v0, v1); } }
    }
};
struct EpiSloc {
    static constexpr bool PERM = false, AFTER_DRAIN = false; unsigned char* ws;
    __device__ __forceinline__ void operator()(const f32x4 (&acc)[2][2][4][2], const Unit& u, int wr, int wc, int fr, int fq) const {
#pragma unroll
        for (int ai = 0; ai < 2; ++ai)
#pragma unroll
            for (int m = 0; m < 4; ++m) { float* rowp = (float*)(ws + WS_SLOC) + (size_t)(u.pm * BM + ai * HALF + wr * 64 + m * 16 + fr) * 256 + wc * 32 + 4 * fq;
#pragma unroll
                for (int bj = 0; bj < 2; ++bj)
#pragma unroll
                    for (int n = 0; n < 2; ++n) *(f32x4*)(rowp + bj * HALF + 16 * n) = acc[ai][bj][m][n]; }
    }
};
struct EpiRows {
    static constexpr bool PERM = true, AFTER_DRAIN = false; bf16_t* O; int ldc;
    __device__ __forceinline__ void operator()(const f32x4 (&acc)[2][2][4][2], const Unit& u, int wr, int wc, int fr, int fq) const {
#pragma unroll
        for (int ai = 0; ai < 2; ++ai)
#pragma unroll
            for (int m = 0; m < 4; ++m) { bf16_t* rowp = O + (size_t)(u.pm * BM + ai * HALF + wr * 64 + m * 16 + fr) * ldc + u.pn * BM + wc * 32 + 8 * fq;
#pragma unroll
                for (int bj = 0; bj < 2; ++bj) *(u32x4*)(rowp + bj * HALF) = pack8(acc[ai][bj][m][0], acc[ai][bj][m][1]); }
    }
};
struct EpiGlu {
    static constexpr bool PERM = true, AFTER_DRAIN = false; unsigned char* ws;
    __device__ __forceinline__ void operator()(const f32x4 (&acc)[2][2][4][2], const Unit& u, int wr, int wc, int fr, int fq) const {
#pragma unroll
        for (int ai = 0; ai < 2; ++ai)
#pragma unroll
            for (int m = 0; m < 4; ++m) { const int row = u.pm * BM + ai * HALF + wr * 64 + m * 16 + fr; f32x4 o[2];
#pragma unroll
                for (int n = 0; n < 2; ++n)
#pragma unroll
                    for (int q = 0; q < 4; ++q) o[n][q] = acc[ai][0][m][n][q] * sigm(acc[ai][1][m][n][q]);
                *(u32x4*)((bf16_t*)(ws + WS_GLU) + (size_t)row * 512 + u.pn * 128 + wc * 32 + 8 * fq) = pack8(o[0], o[1]); }
    }
};
template <int SECOND> struct EpiMerge {
    static constexpr bool PERM = true, AFTER_DRAIN = false; unsigned char* ws;
    __device__ __forceinline__ void operator()(const f32x4 (&acc)[2][2][4][2], const Unit& u, int wr, int wc, int fr, int fq) const {
#pragma unroll
        for (int ai = 0; ai < 2; ++ai)
#pragma unroll
            for (int m = 0; m < 4; ++m) { const int row = u.pm * BM + ai * HALF + wr * 64 + m * 16 + fr;
#pragma unroll
                for (int bj = 0; bj < 2; ++bj) { const int col = u.pn * BM + bj * HALF + wc * 32 + 8 * fq;
                    const u32x4 gt = *(const u32x4*)((const bf16_t*)(ws + WS_GATES) + (size_t)row * 2048 + SECOND * 1024 + col);
                    bf16_t* dst = (bf16_t*)(ws + WS_MERGED) + (size_t)row * 1024 + col;
                    f32x4 v0 = acc[ai][bj][m][0], v1 = acc[ai][bj][m][1];
                    v0[0] *= bfl(gt.x); v0[1] *= bfh(gt.x); v0[2] *= bfl(gt.y); v0[3] *= bfh(gt.y); v1[0] *= bfl(gt.z); v1[1] *= bfh(gt.z); v1[2] *= bfl(gt.w); v1[3] *= bfh(gt.w);
                    if (SECOND) { const u32x4 pv = *(const u32x4*)dst;
                        v0[0] += bfl(pv.x); v0[1] += bfh(pv.x); v0[2] += bfl(pv.y); v0[3] += bfh(pv.y); v1[0] += bfl(pv.z); v1[1] += bfh(pv.z); v1[2] += bfl(pv.w); v1[3] += bfh(pv.w); }
                    *(u32x4*)dst = pack8(v0, v1); }
                if (m == 3) asm volatile("" ::: "memory"); }
    }
};
struct EpiWo {
    static constexpr bool PERM = false, AFTER_DRAIN = false; unsigned char* ws; const float* x;
    __device__ __forceinline__ void operator()(const f32x4 (&acc)[2][2][4][2], const Unit& u, int wr, int wc, int fr, int fq) const {
        const float* g1 = (const float*)(ws + WS_MOD) + (u.pm >> 3) * 6144 + 2048;
#pragma unroll
        for (int ai = 0; ai < 2; ++ai)
#pragma unroll
            for (int m = 0; m < 4; ++m) { const size_t row = (size_t)(u.pm * BM + ai * HALF + wr * 64 + m * 16 + fr);
#pragma unroll
                for (int bj = 0; bj < 2; ++bj)
#pragma unroll
                    for (int n = 0; n < 2; ++n) { const int col = u.pn * BM + bj * HALF + wc * 32 + 16 * n + 4 * fq;
                        const f32x4 xv = *(const f32x4*)(x + row * D + col), gv = *(const f32x4*)(g1 + col);
                        *(f32x4*)((float*)(ws + WS_XL1) + row * D + col) = xv + gv * acc[ai][bj][m][n]; }
                if (m & 1) asm volatile("" ::: "memory"); }
    }
};
struct EpiRS {
    static constexpr bool PERM = true, AFTER_DRAIN = false; unsigned char* ws;
    __device__ __forceinline__ void operator()(const f32x4 (&acc)[2][2][4][2], const Unit& u, int wr, int wc, int fr, int fq) const {
#pragma unroll
        for (int ai = 0; ai < 2; ++ai)
#pragma unroll
            for (int m = 0; m < 4; ++m) { const size_t row = (size_t)(u.pm * BM + ai * HALF + wr * 64 + m * 16 + fr);
                if (u.pn == 0) {
#pragma unroll
                    for (int bj = 0; bj < 2; ++bj)
#pragma unroll
                        for (int n = 0; n < 2; ++n) { f32x4 v = acc[ai][bj][m][n];
#pragma unroll
                            for (int q = 0; q < 4; ++q) v[q] = sigm(v[q]);
                            *(f32x4*)((float*)(ws + WS_SCORES) + row * 256 + bj * HALF + wc * 32 + 8 * fq + 4 * n) = v; }
                } else { f32x4 o[2];
#pragma unroll
                    for (int n = 0; n < 2; ++n)
#pragma unroll
                        for (int q = 0; q < 4; ++q) { const float a = acc[ai][0][m][n][q]; o[n][q] = a * sigm(a) * acc[ai][1][m][n][q]; }
                    *(u32x4*)((bf16_t*)(ws + WS_HS) + row * 256 + (u.pn - 1) * 128 + wc * 32 + 8 * fq) = pack8(o[0], o[1]); } }
    }
};
struct EpiMoe1 {
    static constexpr bool PERM = true, AFTER_DRAIN = false; unsigned char* ws;
    __device__ __forceinline__ void operator()(const f32x4 (&acc)[2][2][4][2], const Unit& u, int wr, int wc, int fr, int fq) const {
#pragma unroll
        for (int ai = 0; ai < 2; ++ai)
#pragma unroll
            for (int m = 0; m < 4; ++m) { const size_t row = (size_t)(u.pm * BM + ai * HALF + wr * 64 + m * 16 + fr); f32x4 o[2];
#pragma unroll
                for (int n = 0; n < 2; ++n)
#pragma unroll
                    for (int q = 0; q < 4; ++q) { const float a = acc[ai][0][m][n][q]; o[n][q] = a * sigm(a) * acc[ai][1][m][n][q]; }
                *(u32x4*)((bf16_t*)(ws + WS_HBUF) + row * 256 + (u.pn & 1) * 128 + wc * 32 + 8 * fq) = pack8(o[0], o[1]); }
    }
};
struct EpiMoe2 {
    static constexpr bool PERM = true, AFTER_DRAIN = false; unsigned char* ws;
    __device__ __forceinline__ void operator()(const f32x4 (&acc)[2][2][4][2], const Unit& u, int wr, int wc, int fr, int fq) const {
        const int* list = (const int*)(ws + WS_LIST) + (size_t)u.e * LIST_CAP + u.mi * BM; const float* tw = (const float*)(ws + WS_TW);
        unsigned char* ys = ws + WS_YSLOT; const unsigned cb = (unsigned)(((u.pn & 3) * BM + wc * 32 + 8 * fq) * 2); const int nvalid = u.cnt - u.mi * BM;
        int ts[2][4]; float w[2][4];
#pragma unroll
        for (int ai = 0; ai < 2; ++ai)
#pragma unroll
            for (int m = 0; m < 4; ++m) { const int rl = ai * HALF + wr * 64 + m * 16 + fr; ts[ai][m] = rl < nvalid ? list[rl] : -1; }
#pragma unroll
        for (int ai = 0; ai < 2; ++ai)
#pragma unroll
            for (int m = 0; m < 4; ++m) w[ai][m] = ts[ai][m] >= 0 ? tw[ts[ai][m]] : 0.f;
#pragma unroll
        for (int ai = 0; ai < 2; ++ai)
#pragma unroll
            for (int m = 0; m < 4; ++m) if (ts[ai][m] >= 0) { const unsigned ob = (unsigned)ts[ai][m] * (unsigned)(D * 2) + cb; const float ww = w[ai][m];
                    *(u32x4*)(ys + ob) = pack8(acc[ai][0][m][0] * ww, acc[ai][0][m][1] * ww);
                    *(u32x4*)(ys + ob + HALF * 2) = pack8(acc[ai][1][m][0] * ww, acc[ai][1][m][1] * ww); }
    }
};
template <class Epi, class Sched, bool ALIGN_EPI = false, bool SP2 = false>
__device__ __forceinline__ void gemm_phase(PG8_LAS unsigned char* lds, const Gemm g, const Sched& S, const Epi& E, const int tid_in) {
    int tid_ = tid_in; asm volatile("" : "+v"(tid_));
    const int tid = tid_, wid = __builtin_amdgcn_readfirstlane(tid >> 6), lane = tid & 63, wr = wid >> 2, wc = wid & 3, fr = lane & 15, fq = lane >> 4;
    const int K = g.K, nt = K / BK;
    unsigned voffA[2], voffB[2];
#pragma unroll
    for (int i = 0; i < 2; ++i) { int R, C; stage_rc(tid * 16 + i * 8192, R, C); const int Rb = Epi::PERM ? ((R & ~31) + perm32(R & 31)) : R;
        voffA[i] = (unsigned)(R * K + C) * 2u; voffB[i] = (unsigned)(Rb * K + C) * 2u; }
    const size_t kstep = (size_t)(BK * 2);
    const size_t hstep = (size_t)HALF * K * 2;
    const size_t tstep = 2 * hstep;
    const unsigned ldsw = (unsigned)wid * 1024u;
    const int aoff = lds_byte(wr * 64 + fr, fq * 8), boff = lds_byte(wc * 32 + fr, fq * 8);
#define PG8_SA(b, h) (((b) * 2 + (h)) * HTB)
#define PG8_SB(b, h) ((4 + (b) * 2 + (h)) * HTB)
#define PG8_STAGE(bufoff, gbase, voff) do { _Pragma("unroll") for (int _i = 0; _i < 2; ++_i) \
        __builtin_amdgcn_global_load_lds((const unsigned*)((const char*)(gbase) + (voff)[_i]), (PG8_LAS unsigned*)(lds + (bufoff) + ldsw + _i * 8192), 16, 0, 0); } while (0)
#define PG8_LDA(dst, b, h) do { _Pragma("unroll") for (int m = 0; m < 4; ++m) _Pragma("unroll") for (int k = 0; k < 2; ++k) dst[m][k] = *(const PG8_LAS bf16x8*)(lds + PG8_SA(b, h) + aoff + m * 2048 + k * 1024); } while (0)
#define PG8_LDB(dst, b, h) do { _Pragma("unroll") for (int n = 0; n < 2; ++n) _Pragma("unroll") for (int k = 0; k < 2; ++k) dst[n][k] = *(const PG8_LAS bf16x8*)(lds + PG8_SB(b, h) + boff + n * 2048 + k * 1024); } while (0)
#define PG8_MMA(ai, bj, At, Bt) do { __builtin_amdgcn_s_setprio(1); _Pragma("unroll") for (int m = 0; m < 4; ++m) _Pragma("unroll") for (int n = 0; n < 2; ++n) _Pragma("unroll") for (int k = 0; k < 2; ++k) \
        acc[ai][bj][m][n] = __builtin_amdgcn_mfma_f32_16x16x32_bf16(Bt[n][k], At[m][k], acc[ai][bj][m][n], 0, 0, 0); __builtin_amdgcn_s_setprio(0); } while (0)
#define PG8_WAIT_V(n) asm volatile("s_waitcnt vmcnt(" #n ")" ::: "memory")
#define PG8_WAIT_L(n) asm volatile("s_waitcnt lgkmcnt(" #n ")" ::: "memory")
#define PG8_BAR __builtin_amdgcn_s_barrier()
#define PG8_SCHED __builtin_amdgcn_sched_barrier(0)
    Unit cur, nxt; int ui = 0;
    if (!S.next(0, cur)) return;
    f32x4 acc[2][2][4][2];
#pragma unroll
    for (int a = 0; a < 2; ++a)
#pragma unroll
        for (int b = 0; b < 2; ++b)
#pragma unroll
            for (int m = 0; m < 4; ++m)
#pragma unroll
                for (int n = 0; n < 2; ++n) acc[a][b][m][n] = (f32x4){0.f, 0.f, 0.f, 0.f};
    bf16x8 At[4][2], B0[2][2], B1[2][2];
    const char* cA = (const char*)g.A + (size_t)cur.pm * tstep; const char* cB = (const char*)g.Bt + (size_t)cur.pn * tstep;
    S.a_ready(cur);
    if constexpr (SP2) {
        PG8_STAGE(PG8_SB(0, 0), cB, voffB); PG8_STAGE(PG8_SB(0, 1), cB + hstep, voffB); PG8_STAGE(PG8_SA(0, 0), cA, voffA); PG8_STAGE(PG8_SA(0, 1), cA + hstep, voffA);
        if (wr == 1) PG8_BAR;
        PG8_WAIT_V(2); PG8_BAR;
        PG8_STAGE(PG8_SB(1, 0), cB + kstep, voffB); PG8_STAGE(PG8_SA(1, 0), cA + kstep, voffA); PG8_STAGE(PG8_SB(1, 1), cB + hstep + kstep, voffB);
        PG8_WAIT_V(6); PG8_BAR;
    } else {
        PG8_STAGE(PG8_SB(0, 0), cB, voffB); PG8_STAGE(PG8_SA(0, 0), cA, voffA); PG8_STAGE(PG8_SB(0, 1), cB + hstep, voffB); PG8_STAGE(PG8_SA(0, 1), cA + hstep, voffA);
        if (wr == 1) PG8_BAR;
        PG8_WAIT_V(4); PG8_BAR;
        PG8_STAGE(PG8_SB(1, 0), cB + kstep, voffB); PG8_STAGE(PG8_SA(1, 0), cA + kstep, voffA); PG8_STAGE(PG8_SB(1, 1), cB + hstep + kstep, voffB);
        PG8_WAIT_V(6); PG8_BAR;
    }
    for (;;) {
        const bool has_next = S.next(ui + 1, nxt);
        const char* nA = has_next ? (const char*)g.A + (size_t)nxt.pm * tstep : cA; const char* nB = has_next ? (const char*)g.Bt + (size_t)nxt.pn * tstep : cB;
#pragma unroll 1
        for (int t = 0; t < nt; t += 2) {
            const bool last = (t == nt - 2);
            const char* a1 = cA + (size_t)(t + 1) * kstep;
            const char* a2 = last ? nA : cA + (size_t)(t + 2) * kstep; const char* b2 = last ? nB : cB + (size_t)(t + 2) * kstep;
            const char* a3 = a2 + kstep; const char* b3 = b2 + kstep;
            if (last && has_next) S.a_ready(nxt);
            if constexpr (SP2) {
            PG8_LDB(B0, 0, 0); PG8_LDB(B1, 0, 1); PG8_SCHED; PG8_LDA(At, 0, 0); PG8_STAGE(PG8_SA(1, 1), a1 + hstep, voffA);
            PG8_WAIT_V(8); PG8_WAIT_L(0); PG8_BAR; PG8_MMA(0, 0, At, B0); PG8_MMA(0, 1, At, B1); PG8_BAR; PG8_SCHED;
            PG8_LDA(At, 0, 1); PG8_STAGE(PG8_SB(0, 0), b2, voffB); PG8_STAGE(PG8_SB(0, 1), b2 + hstep, voffB); PG8_STAGE(PG8_SA(0, 0), a2, voffA);
            PG8_WAIT_V(8); PG8_WAIT_L(0); PG8_BAR; PG8_MMA(1, 0, At, B0); PG8_MMA(1, 1, At, B1); PG8_BAR; PG8_SCHED;
            PG8_LDB(B0, 1, 0); PG8_LDB(B1, 1, 1); PG8_SCHED; PG8_LDA(At, 1, 0); PG8_STAGE(PG8_SA(0, 1), a2 + hstep, voffA);
            PG8_WAIT_V(8); PG8_WAIT_L(0); PG8_BAR; PG8_MMA(0, 0, At, B0); PG8_MMA(0, 1, At, B1); PG8_BAR; PG8_SCHED;
            PG8_LDA(At, 1, 1); PG8_STAGE(PG8_SB(1, 0), b3, voffB); PG8_STAGE(PG8_SB(1, 1), b3 + hstep, voffB); PG8_STAGE(PG8_SA(1, 0), a3, voffA);
            PG8_WAIT_V(8); PG8_WAIT_L(0); PG8_BAR; PG8_MMA(1, 0, At, B0); PG8_MMA(1, 1, At, B1); PG8_BAR; PG8_SCHED;
            } else {
            PG8_LDB(B0, 0, 0); PG8_SCHED; PG8_LDA(At, 0, 0); PG8_STAGE(PG8_SA(1, 1), a1 + hstep, voffA);
            PG8_WAIT_L(8); PG8_BAR; PG8_WAIT_L(0); PG8_MMA(0, 0, At, B0); PG8_BAR; PG8_SCHED;
            PG8_LDB(B1, 0, 1); PG8_STAGE(PG8_SB(0, 0), b2, voffB);
            PG8_BAR; PG8_WAIT_L(0); PG8_MMA(0, 1, At, B1); PG8_BAR;
            PG8_LDA(At, 0, 1); PG8_STAGE(PG8_SA(0, 0), a2, voffA);
            PG8_BAR; PG8_WAIT_L(0); PG8_MMA(1, 0, At, B0); PG8_BAR; PG8_SCHED;
            PG8_STAGE(PG8_SB(0, 1), b2 + hstep, voffB);
            PG8_WAIT_V(6); PG8_BAR; PG8_MMA(1, 1, At, B1); PG8_BAR;
            PG8_LDB(B0, 1, 0); PG8_SCHED; PG8_LDA(At, 1, 0); PG8_STAGE(PG8_SA(0, 1), a2 + hstep, voffA);
            PG8_WAIT_L(8); PG8_BAR; PG8_WAIT_L(0); PG8_MMA(0, 0, At, B0); PG8_BAR; PG8_SCHED;
            PG8_LDB(B1, 1, 1); PG8_STAGE(PG8_SB(1, 0), b3, voffB);
            PG8_BAR; PG8_WAIT_L(0); PG8_MMA(0, 1, At, B1); PG8_BAR;
            PG8_LDA(At, 1, 1); PG8_STAGE(PG8_SA(1, 0), a3, voffA);
            PG8_BAR; PG8_WAIT_L(0); PG8_MMA(1, 0, At, B0); PG8_BAR; PG8_SCHED;
            PG8_STAGE(PG8_SB(1, 1), b3 + hstep, voffB);
            PG8_WAIT_V(6); PG8_BAR; PG8_MMA(1, 1, At, B1); PG8_BAR;
            }
        }
        if constexpr (ALIGN_EPI) { if (wr == 0) PG8_BAR; }
        if constexpr (!Epi::AFTER_DRAIN) { E(acc, cur, wr, wc, fr, fq); S.done(cur); }
        if (!has_next) break;
#pragma unroll
        for (int a = 0; a < 2; ++a)
#pragma unroll
            for (int b = 0; b < 2; ++b)
#pragma unroll
                for (int m = 0; m < 4; ++m)
#pragma unroll
                    for (int n = 0; n < 2; ++n) acc[a][b][m][n] = (f32x4){0.f, 0.f, 0.f, 0.f};
        cur = nxt; cA = nA; cB = nB; ++ui;
        if constexpr (ALIGN_EPI) { if (wr == 1) PG8_BAR; }
    }
    PG8_WAIT_V(0);
    if constexpr (!ALIGN_EPI) { if (wr == 0) PG8_BAR; }
    PG8_BAR;
    if constexpr (Epi::AFTER_DRAIN) { E.fused(acc, cur, wr, wc, fr, fq, lds, wid, lane); S.done(cur); }
#undef PG8_SA
#undef PG8_SB
#undef PG8_STAGE
#undef PG8_LDA
#undef PG8_LDB
#undef PG8_MMA
#undef PG8_WAIT_V
#undef PG8_WAIT_L
#undef PG8_BAR
#undef PG8_SCHED
}


template <class Epi, class Sched, class Gather, bool ALIGN_EPI = false>
__device__ __forceinline__ void gemm_phase_gather(PG8_LAS unsigned char* lds, const Gemm g, const Sched& S, const Epi& E, const Gather& GA, const int tid_in) {
    constexpr bool SP2 = true;
    int tid_ = tid_in; asm volatile("" : "+v"(tid_));
    const int tid = tid_, wid = __builtin_amdgcn_readfirstlane(tid >> 6), lane = tid & 63, wr = wid >> 2, wc = wid & 3, fr = lane & 15, fq = lane >> 4;
    const int K = g.K, nt = K / BK;
    unsigned voffB[2]; int gR[2], gC[2];
#pragma unroll
    for (int i = 0; i < 2; ++i) { int R, C; stage_rc(tid * 16 + i * 8192, R, C); const int Rb = Epi::PERM ? ((R & ~31) + perm32(R & 31)) : R;
        gR[i] = R; gC[i] = C; voffB[i] = (unsigned)(Rb * K + C) * 2u; }
    unsigned vc[2][2], vn[2][2];
    const size_t kstep = (size_t)(BK * 2);
    const size_t hstep = (size_t)HALF * K * 2;
    const size_t tstep = 2 * hstep;
    const unsigned ldsw = (unsigned)wid * 1024u;
    const int aoff = lds_byte(wr * 64 + fr, fq * 8), boff = lds_byte(wc * 32 + fr, fq * 8);
#define PG8_SA(b, h) (((b) * 2 + (h)) * HTB)
#define PG8_SB(b, h) ((4 + (b) * 2 + (h)) * HTB)
#define PG8_STAGE(bufoff, gbase, voff) do { _Pragma("unroll") for (int _i = 0; _i < 2; ++_i) \
        __builtin_amdgcn_global_load_lds((const unsigned*)((const char*)(gbase) + (voff)[_i]), (PG8_LAS unsigned*)(lds + (bufoff) + ldsw + _i * 8192), 16, 0, 0); } while (0)
#define PG8_LDA(dst, b, h) do { _Pragma("unroll") for (int m = 0; m < 4; ++m) _Pragma("unroll") for (int k = 0; k < 2; ++k) dst[m][k] = *(const PG8_LAS bf16x8*)(lds + PG8_SA(b, h) + aoff + m * 2048 + k * 1024); } while (0)
#define PG8_LDB(dst, b, h) do { _Pragma("unroll") for (int n = 0; n < 2; ++n) _Pragma("unroll") for (int k = 0; k < 2; ++k) dst[n][k] = *(const PG8_LAS bf16x8*)(lds + PG8_SB(b, h) + boff + n * 2048 + k * 1024); } while (0)
#define PG8_MMA(ai, bj, At, Bt) do { __builtin_amdgcn_s_setprio(1); _Pragma("unroll") for (int m = 0; m < 4; ++m) _Pragma("unroll") for (int n = 0; n < 2; ++n) _Pragma("unroll") for (int k = 0; k < 2; ++k) \
        acc[ai][bj][m][n] = __builtin_amdgcn_mfma_f32_16x16x32_bf16(Bt[n][k], At[m][k], acc[ai][bj][m][n], 0, 0, 0); __builtin_amdgcn_s_setprio(0); } while (0)
#define PG8_WAIT_V(n) asm volatile("s_waitcnt vmcnt(" #n ")" ::: "memory")
#define PG8_WAIT_L(n) asm volatile("s_waitcnt lgkmcnt(" #n ")" ::: "memory")
#define PG8_BAR __builtin_amdgcn_s_barrier()
#define PG8_SCHED __builtin_amdgcn_sched_barrier(0)
    Unit cur, nxt; int ui = 0;
    if (!S.next(0, cur)) return;
    f32x4 acc[2][2][4][2];
#pragma unroll
    for (int a = 0; a < 2; ++a)
#pragma unroll
        for (int b = 0; b < 2; ++b)
#pragma unroll
            for (int m = 0; m < 4; ++m)
#pragma unroll
                for (int n = 0; n < 2; ++n) acc[a][b][m][n] = (f32x4){0.f, 0.f, 0.f, 0.f};
    bf16x8 At[4][2], B0[2][2], B1[2][2];
    const char* const gA = (const char*)g.A; const char* cB = (const char*)g.Bt + (size_t)cur.pn * tstep;
#pragma unroll
    for (int h = 0; h < 2; ++h)
#pragma unroll
        for (int i = 0; i < 2; ++i) vc[h][i] = GA.row_off(cur, h * HALF + gR[i]) + (unsigned)gC[i] * 2u;
    S.a_ready(cur);
    if constexpr (SP2) {
        PG8_STAGE(PG8_SB(0, 0), cB, voffB); PG8_STAGE(PG8_SB(0, 1), cB + hstep, voffB); PG8_STAGE(PG8_SA(0, 0), gA, vc[0]); PG8_STAGE(PG8_SA(0, 1), gA, vc[1]);
        if (wr == 1) PG8_BAR;
        PG8_WAIT_V(2); PG8_BAR;
        PG8_STAGE(PG8_SB(1, 0), cB + kstep, voffB); PG8_STAGE(PG8_SA(1, 0), gA + kstep, vc[0]); PG8_STAGE(PG8_SB(1, 1), cB + hstep + kstep, voffB);
        PG8_WAIT_V(6); PG8_BAR;
    }
    for (;;) {
        const bool has_next = S.next(ui + 1, nxt);
        const char* nB = has_next ? (const char*)g.Bt + (size_t)nxt.pn * tstep : cB;
#pragma unroll
        for (int h = 0; h < 2; ++h)
#pragma unroll
            for (int i = 0; i < 2; ++i) vn[h][i] = has_next ? GA.row_off(nxt, h * HALF + gR[i]) + (unsigned)gC[i] * 2u : vc[h][i];
#pragma unroll 1
        for (int t = 0; t < nt; t += 2) {
            const bool last = (t == nt - 2);
            const char* a1 = gA + (size_t)(t + 1) * kstep;
            const char* a2 = last ? gA : gA + (size_t)(t + 2) * kstep; const char* b2 = last ? nB : cB + (size_t)(t + 2) * kstep;
            unsigned v2[2][2];
#pragma unroll
            for (int h = 0; h < 2; ++h)
#pragma unroll
                for (int i = 0; i < 2; ++i) v2[h][i] = last ? vn[h][i] : vc[h][i];
            const char* a3 = a2 + kstep; const char* b3 = b2 + kstep;
            if (last && has_next) S.a_ready(nxt);
            if constexpr (SP2) {
            PG8_LDB(B0, 0, 0); PG8_LDB(B1, 0, 1); PG8_SCHED; PG8_LDA(At, 0, 0); PG8_STAGE(PG8_SA(1, 1), a1, vc[1]);
            PG8_WAIT_V(8); PG8_WAIT_L(0); PG8_BAR; PG8_MMA(0, 0, At, B0); PG8_MMA(0, 1, At, B1); PG8_BAR; PG8_SCHED;
            PG8_LDA(At, 0, 1); PG8_STAGE(PG8_SB(0, 0), b2, voffB); PG8_STAGE(PG8_SB(0, 1), b2 + hstep, voffB); PG8_STAGE(PG8_SA(0, 0), a2, v2[0]);
            PG8_WAIT_V(8); PG8_WAIT_L(0); PG8_BAR; PG8_MMA(1, 0, At, B0); PG8_MMA(1, 1, At, B1); PG8_BAR; PG8_SCHED;
            PG8_LDB(B0, 1, 0); PG8_LDB(B1, 1, 1); PG8_SCHED; PG8_LDA(At, 1, 0); PG8_STAGE(PG8_SA(0, 1), a2, v2[1]);
            PG8_WAIT_V(8); PG8_WAIT_L(0); PG8_BAR; PG8_MMA(0, 0, At, B0); PG8_MMA(0, 1, At, B1); PG8_BAR; PG8_SCHED;
            PG8_LDA(At, 1, 1); PG8_STAGE(PG8_SB(1, 0), b3, voffB); PG8_STAGE(PG8_SB(1, 1), b3 + hstep, voffB); PG8_STAGE(PG8_SA(1, 0), a3, v2[0]);
            PG8_WAIT_V(8); PG8_WAIT_L(0); PG8_BAR; PG8_MMA(1, 0, At, B0); PG8_MMA(1, 1, At, B1); PG8_BAR; PG8_SCHED;
            }
        }
        if constexpr (ALIGN_EPI) { if (wr == 0) PG8_BAR; }
        if constexpr (!Epi::AFTER_DRAIN) { E(acc, cur, wr, wc, fr, fq); S.done(cur); }
        if (!has_next) break;
#pragma unroll
        for (int a = 0; a < 2; ++a)
#pragma unroll
            for (int b = 0; b < 2; ++b)
#pragma unroll
                for (int m = 0; m < 4; ++m)
#pragma unroll
                    for (int n = 0; n < 2; ++n) acc[a][b][m][n] = (f32x4){0.f, 0.f, 0.f, 0.f};
        cur = nxt; cB = nB; ++ui;
#pragma unroll
        for (int h = 0; h < 2; ++h)
#pragma unroll
            for (int i = 0; i < 2; ++i) vc[h][i] = vn[h][i];
        if constexpr (ALIGN_EPI) { if (wr == 1) PG8_BAR; }
    }
    PG8_WAIT_V(0);
    if constexpr (!ALIGN_EPI) { if (wr == 0) PG8_BAR; }
    PG8_BAR;
    if constexpr (Epi::AFTER_DRAIN) { E.fused(acc, cur, wr, wc, fr, fq, lds, wid, lane); S.done(cur); }
#undef PG8_SA
#undef PG8_SB
#undef PG8_STAGE
#undef PG8_LDA
#undef PG8_LDB
#undef PG8_MMA
#undef PG8_WAIT_V
#undef PG8_WAIT_L
#undef PG8_BAR
#undef PG8_SCHED
}
}

constexpr int NWAVES = 8, NTHREADS = NWAVES * 64;
constexpr int RING_BYTES = 131072, LDSCTL_OFF = RING_BYTES, LDS_BYTES = 147456;
constexpr int CW_BAR = 4096;
static_assert(CW_BAR + XCD_BAR_WORDS <= CW_CNT && (CW_CNT + NE * CNT_STRIDE) * 4 <= (int)MiB, "control words inside the memset region");
static_assert(SSM_LDS_BYTES <= RING_BYTES && (9 * 1024 + 21 * 24 * 9) * 4 <= RING_BYTES && NWAVES * 64 * 33 * 4 <= RING_BYTES, "LDS scratch fits the ring region");

typedef const __attribute__((address_space(4))) Ptrs* KPtrs;
__device__ __forceinline__ Ptrs load_ptrs(KPtrs p) { Ptrs r;
#pragma unroll
    for (int i = 0; i < 31; ++i) r.in[i] = p->in[i];
    r.out = p->out; r.ws = p->ws; return r; }
__global__ void __launch_bounds__(NTHREADS, 2) mega(Ptrs P_kernarg  ) {
    extern __shared__ __attribute__((aligned(16))) unsigned char lds[];
    const int G = gridDim.x; const int bx = blockIdx.x; const int vcu = (G % 8 == 0) ? (bx % 8) * (G / 8) + bx / 8 : bx;
    const int NGW = G * NWAVES;
    const int wave = __builtin_amdgcn_readfirstlane(threadIdx.x >> 6);
#define IDS() int lane_ = __builtin_amdgcn_mbcnt_hi(~0u, __builtin_amdgcn_mbcnt_lo(~0u, 0u)); asm volatile("" : "+v"(lane_)); const int lane = lane_, tid = wave * 64 + lane, gw = vcu * NWAVES + wave; (void)gw; \
    KPtrs kp_ = (KPtrs)__builtin_amdgcn_kernarg_segment_ptr(); asm volatile("" : "+s"(kp_)); const Ptrs P = load_ptrs(kp_);   \
    unsigned char* ws = P.ws; const float* mod = (const float*)(ws + WS_MOD); (void)mod
    for (int u = threadIdx.x; u < (LDS_BYTES - LDSCTL_OFF) / 4; u += NTHREADS) ((unsigned*)(lds + LDSCTL_OFF))[u] = 0u;
    __syncthreads();
    XcdBarrier bar = xcd_barrier_post((unsigned*)(((KPtrs)__builtin_amdgcn_kernarg_segment_ptr())->ws + WS_CTL) + CW_BAR, (volatile LAS unsigned*)(lds + LDSCTL_OFF), (int)threadIdx.x);
#define GRID_BAR() xcd_barrier(bar, wave * 64 + (int)__builtin_amdgcn_mbcnt_hi(~0u, __builtin_amdgcn_mbcnt_lo(~0u, 0u)))
#ifndef DUP_MASK
#define DUP_MASK 0
#endif
#define REP(k) for (int rep_ = 0; rep_ < 1 + ((DUP_MASK >> (k)) & 1); ++rep_)
    PG8_LAS unsigned char* ring = (PG8_LAS unsigned char*)lds;

    REP(0) {
    { IDS();
    for (int g = vcu; g < SG; g += G) ssm_tables_item(P, g, lds, tid, NTHREADS);
    }
    { IDS();
    for (int cb = vcu; cb < 256; cb += G) mod_cols(P, cb, (float*)lds, tid, NTHREADS);
    __syncthreads();
    }
#define WPREP(KIND, W, ldw, OFF, ldt, nkb, nnb, roff, nbatch, wstr, tstr, WOFF) { IDS(); wprep_loop<KIND>(W, ldw, (bf16*)(ws + OFF), ldt, nkb, nnb, roff, nbatch, wstr, tstr, (float*)lds + wave * (64 * 33), lane, gw, NGW, WOFF); }
    WPREP(0, P.in[8], INC, WS_WIN_T, D, 16, 128, 0, 1, 0, 0, 0)
    WPREP(1, P.in[17], 1024, WS_WGLU_T, 512, 8, 32, 0, 1, 0, 0, 0)
    WPREP(0, P.in[18], 1024, WS_WSSM_T, 512, 8, 32, 0, 1, 0, 0, 256)
    WPREP(0, P.in[20], 1024, WS_WCONV_T, 512, 8, 32, 0, 1, 0, 0, 512)
    WPREP(0, P.in[21], 1024, WS_WO_T, 1024, 16, 32, 0, 1, 0, 0, 768)
    WPREP(0, P.in[22], 256, WS_WRS_T, 1024, 16, 8, 0, 1, 0, 0, 1280)
    WPREP(2, P.in[27], 256, WS_WRS_T, 1024, 16, 8, 256, 1, 0, 0, 1408)
    WPREP(2, P.in[28], 256, WS_WRS_T, 1024, 16, 8, 384, 1, 0, 0, 1536)
    WPREP(0, P.in[29], 1024, WS_WSD_T, 256, 4, 32, 0, 1, 0, 0, 1664)
#undef WPREP
    { IDS(); __syncthreads(); xpose_experts(P.in[24], P.in[25], P.in[26], (bf16*)(ws + WS_WGU_T), (bf16*)(ws + WS_WD_T), (float*)lds, tid, bx, G); }
    GRID_BAR(); }
    REP(1) {
    { IDS();
    for (int r = gw; r < NROW; r += NGW) {
        const bool lat = r < NTOK; const int mr = lat ? r / SEQ : 8;
        const float* xrow = lat ? P.in[0] + (size_t)r * D : P.in[2] + (size_t)(r - NTOK) * D;
        norm_mod_row(xrow, P.in[6], mod + mr * 6144 + 1024, mod + mr * 6144 + 0, (bf16*)(ws + WS_H1) + (size_t)r * D, lane);
    }
    }
    GRID_BAR(); }
    REP(2) {
    { IDS();
    { pg8::Gemm g{(const bf16*)(ws + WS_H1), (const bf16*)(ws + WS_WIN_T), NROW, INC, D}; pg8::ProjOrder S; S.init(G, bx); pg8::EpiProj E{ws};
      pg8::gemm_phase<pg8::EpiProj, pg8::ProjOrder, true, true>(ring, g, S, E, tid); }
    }
    GRID_BAR(); }
    REP(3) {
    { IDS();
    {
        const bf16* cbv = (const bf16*)(ws + WS_CBV); bf16* cbr = (bf16*)(ws + WS_CBR); const float* cw = P.in[19];
        for (int i = vcu * NTHREADS + tid; i < NTOK * 64; i += G * NTHREADS) {
            const int tok = i >> 6, j8 = (i & 63) * 8, col = tok & 63;
            const bf16* r = cbv + (size_t)tok * 1536;
            const u32x4 cb4 = *(const u32x4*)(r + j8), cc1 = *(const u32x4*)(r + 512 + j8), cv1 = *(const u32x4*)(r + 1024 + j8);
            u32x4 cc0 = (u32x4){0u, 0u, 0u, 0u}, cv0 = cc0, cc2 = cc0, cv2 = cc0;
            if (col > 0) { cc0 = *(const u32x4*)(r - 1536 + 512 + j8); cv0 = *(const u32x4*)(r - 1536 + 1024 + j8); }
            if (col < 63) { cc2 = *(const u32x4*)(r + 1536 + 512 + j8); cv2 = *(const u32x4*)(r + 1536 + 1024 + j8); }
            const f32x4 w0a = *(const f32x4*)(cw + j8), w0b = *(const f32x4*)(cw + j8 + 4), w1a = *(const f32x4*)(cw + 512 + j8), w1b = *(const f32x4*)(cw + 512 + j8 + 4),
                        w2a = *(const f32x4*)(cw + 1024 + j8), w2b = *(const f32x4*)(cw + 1024 + j8 + 4);
            float o[8];
#pragma unroll
            for (int q = 0; q < 4; ++q) {
                const unsigned b_ = cb4[q], c0 = cc0[q], v0 = cv0[q], c1 = cc1[q], v1 = cv1[q], c2 = cc2[q], v2 = cv2[q];
                const float wl0 = q < 2 ? w0a[2 * q] : w0b[2 * q - 4], wh0 = q < 2 ? w0a[2 * q + 1] : w0b[2 * q - 3];
                const float wl1 = q < 2 ? w1a[2 * q] : w1b[2 * q - 4], wh1 = q < 2 ? w1a[2 * q + 1] : w1b[2 * q - 3];
                const float wl2 = q < 2 ? w2a[2 * q] : w2b[2 * q - 4], wh2 = q < 2 ? w2a[2 * q + 1] : w2b[2 * q - 3];
                o[2 * q] = bf2f(b_) * (wl0 * bf2f(c0) * bf2f(v0) + wl1 * bf2f(c1) * bf2f(v1) + wl2 * bf2f(c2) * bf2f(v2));
                o[2 * q + 1] = bf2f(b_ >> 16) * (wh0 * bf2f(c0 >> 16) * bf2f(v0 >> 16) + wh1 * bf2f(c1 >> 16) * bf2f(v1 >> 16) + wh2 * bf2f(c2 >> 16) * bf2f(v2 >> 16)); }
            u32x4 ov; ov.x = pk2(o[0], o[1]); ov.y = pk2(o[2], o[3]); ov.z = pk2(o[4], o[5]); ov.w = pk2(o[6], o[7]);
            *(u32x4*)(cbr + (size_t)tok * 512 + j8) = ov;
        }
        __syncthreads();
        { pg8::Gemm g{(const bf16*)(ws + WS_AG), (const bf16*)(ws + WS_WINS), SG * AGR, SG * 256, 512}; pg8::SsmOrder S{G, bx, 5}; pg8::EpiSloc E{ws};
          pg8::gemm_phase<pg8::EpiSloc, pg8::SsmOrder, true, true>(ring, g, S, E, tid); }
    }
    }
    GRID_BAR(); }
    REP(4) {
    { IDS();
    for (int it = gw; it < SG * 2 * NB; it += NGW) {
        const int p = lane, b = it % 8, d = (it / 8) % 2, g = it / 16;
        const float* a16 = (const float*)(ws + WS_A16); const float ar = a16[((g * 2 + d) * 64 + p) * 2], ai = a16[((g * 2 + d) * 64 + p) * 2 + 1];
        const float* sl = (const float*)(ws + WS_SLOC) + (size_t)g * AGR * 256 + d * 128 + p;
        bf16* ag = (bf16*)(ws + WS_AG) + ((size_t)g * AGR + b * NCH) * 512 + 256 + d * 128 + p;
        float sr = 0.f, si = 0.f;
        {
            float lr[16], li[16];
#pragma unroll
            for (int j = 0; j < 16; ++j) { const int k = d == 0 ? j : 15 - j; const float* q = sl + (size_t)(1024 + b * NCHC + k) * 256; lr[j] = q[0]; li[j] = q[64]; }
#pragma unroll
            for (int j = 0; j < 16; ++j) { const float nr = ar * sr - ai * si + lr[j], ni = ar * si + ai * sr + li[j]; sr = nr; si = ni; }
        }
        for (int blk = 0; blk < NCH / 16; ++blk) {
            float lr[16], li[16];
#pragma unroll
            for (int j = 0; j < 16; ++j) { const int kk = blk * 16 + j, k = d == 0 ? kk : NCH - 1 - kk; const float* q = sl + (size_t)(b * NCH + k) * 256; lr[j] = q[0]; li[j] = q[64]; }
#pragma unroll
            for (int j = 0; j < 16; ++j) { const int kk = blk * 16 + j, k = d == 0 ? kk : NCH - 1 - kk;
                ag[(size_t)k * 512] = (bf16)f2bf(sr); ag[(size_t)k * 512 + 64] = (bf16)f2bf(si);
                const float nr = ar * sr - ai * si + lr[j], ni = ar * si + ai * sr + li[j]; sr = nr; si = ni; }
        }
    }
    }
    GRID_BAR(); }
    REP(5) {
    { IDS();
    { pg8::Gemm g{(const bf16*)(ws + WS_AG), (const bf16*)(ws + WS_MG), SG * AGR, SG * 256, 512}; pg8::SsmOrder S{G, bx, 4}; pg8::EpiSsmOut E{ws};
      pg8::gemm_phase<pg8::EpiSsmOut, pg8::SsmOrder, true, true>(ring, g, S, E, tid); }
    }
    GRID_BAR(); }
    REP(6) {
    { IDS();
    { pg8::Gemm g{(const bf16*)(ws + WS_YG), (const bf16*)(ws + WS_WGLU_T), NTOK, 1024, 512}; pg8::PlainOrder S; S.init(NTOK, 1024, G, bx); pg8::EpiGlu E{ws};
      pg8::gemm_phase<pg8::EpiGlu, pg8::PlainOrder, true, true>(ring, g, S, E, tid); }
    }
    GRID_BAR(); }
    REP(7) {
    { IDS();
    { pg8::Gemm g{(const bf16*)(ws + WS_GLU), (const bf16*)(ws + WS_WSSM_T), NTOK, 1024, 512}; pg8::PlainOrder S; S.init(NTOK, 1024, G, bx); pg8::EpiMerge<0> E{ws};
      pg8::gemm_phase<pg8::EpiMerge<0>, pg8::PlainOrder, true, true>(ring, g, S, E, tid); }
    { pg8::Gemm g{(const bf16*)(ws + WS_CBR), (const bf16*)(ws + WS_WCONV_T), NTOK, 1024, 512}; pg8::PlainOrder S; S.init(NTOK, 1024, G, bx); pg8::EpiMerge<1> E{ws};
      pg8::gemm_phase<pg8::EpiMerge<1>, pg8::PlainOrder, true, true>(ring, g, S, E, tid); }
    }
    GRID_BAR(); }
    REP(8) {
    { IDS();
    { pg8::Gemm g{(const bf16*)(ws + WS_MERGED), (const bf16*)(ws + WS_WO_T), NTOK, 1024, 1024}; pg8::PlainOrder S; S.init(NTOK, 1024, G, bx); pg8::EpiWo E{ws, P.in[0]};
      pg8::gemm_phase<pg8::EpiWo, pg8::PlainOrder, true, true>(ring, g, S, E, tid); }
    }
    GRID_BAR(); }
    REP(9) {
    { IDS();
    for (int r = gw; r < NTOK; r += NGW) { const int b = r / SEQ;
        norm_mod_row((const float*)(ws + WS_XL1) + (size_t)r * D, P.in[7], mod + b * 6144 + 4096, mod + b * 6144 + 3072, (bf16*)(ws + WS_H2) + (size_t)r * D, lane); }
    }
    GRID_BAR(); }
    REP(10) {
    { IDS();
    { pg8::Gemm g{(const bf16*)(ws + WS_H2), (const bf16*)(ws + WS_WRS_T), NTOK, 768, 1024}; pg8::PlainOrder S; S.init(NTOK, 768, G, bx); pg8::EpiRS E{ws};
      pg8::gemm_phase<pg8::EpiRS, pg8::PlainOrder, true, true>(ring, g, S, E, tid); }
    }
    GRID_BAR(); }
    REP(11) {
    { IDS();
    for (int tok = gw; tok < NTOK; tok += NGW) route_token(P, tok, lane);
    { pg8::Gemm g{(const bf16*)(ws + WS_HS), (const bf16*)(ws + WS_WSD_T), NTOK, 1024, 256}; pg8::PlainOrder S; S.init(NTOK, 1024, G, bx); pg8::EpiRows E{(bf16*)(ws + WS_YS9), D};
      pg8::gemm_phase<pg8::EpiRows, pg8::PlainOrder, true, true>(ring, g, S, E, tid); }
    }
    GRID_BAR(); }
    PG8_LAS int* ts = (PG8_LAS int*)(lds + LDSCTL_OFF + 64);
    PG8_LAS unsigned* offs = (PG8_LAS unsigned*)(lds + LDSCTL_OFF + 2048);
    REP(12) {
    { IDS();
    const unsigned* cntp = (const unsigned*)(ws + WS_CTL) + CW_CNT;
    if (wave == 0) {
        int c4[4], s = 0;
#pragma unroll
        for (int i = 0; i < 4; ++i) { c4[i] = ((int)__hip_atomic_load(&cntp[(lane * 4 + i) * CNT_STRIDE], __ATOMIC_RELAXED, __HIP_MEMORY_SCOPE_AGENT) + 255) >> 8; s += c4[i]; }
        int incl = s;
#pragma unroll
        for (int o = 1; o < 64; o <<= 1) { const int v = __shfl_up(incl, o); if (lane >= o) incl += v; }
        int ex = incl - s;
#pragma unroll
        for (int i = 0; i < 4; ++i) { ts[lane * 4 + i] = ex; ex += c4[i]; }
        if (lane == 63) ts[256] = incl;
    }
    __syncthreads();
    {
        PG8_LAS int* ut = (PG8_LAS int*)(lds + LDSCTL_OFF + 1280);
        int nun = 0; if (wave == 0) nun = pg8::moe_unit_table(ut, ts, cntp, 2, G, bx, lane);
        nun = __builtin_amdgcn_readfirstlane(__shfl(nun, 0)); if (wave == 0) ut[16 * 8] = nun;
        __syncthreads();
        nun = ut[16 * 8]; if (nun > 12) nun = 12;
        pg8::TableOrder S{ut, __builtin_amdgcn_readfirstlane(nun)};
        for (int i = 0; i < 12; ++i) { pg8::Unit u; if (!S.next(i, u)) break;
            if (tid < 256) { const int idx = u.mi * 256 + tid; const int tok = idx < u.cnt ? (((const int*)(ws + WS_LIST))[(size_t)u.e * LIST_CAP + idx] >> 3) : 0; offs[i * 256 + tid] = (unsigned)tok * (unsigned)(D * 2); } }
        __syncthreads();
        pg8::Gemm g{(const bf16*)(ws + WS_H2), (const bf16*)(ws + WS_WGU_T), NTOK, NE * 512, 1024}; pg8::EpiMoe1 E{ws}; pg8::LdsGather GA{offs};
        pg8::gemm_phase_gather<pg8::EpiMoe1, pg8::TableOrder, pg8::LdsGather, true>(ring, g, S, E, GA, tid);
    }
    }
    GRID_BAR(); }
    REP(13) {
    { IDS();
    { const unsigned* cntp = (const unsigned*)(ws + WS_CTL) + CW_CNT; PG8_LAS int* ut = (PG8_LAS int*)(lds + LDSCTL_OFF + 1280);
      __syncthreads();
      int nun = 0; if (wave == 0) nun = pg8::moe_unit_table(ut, ts, cntp, 4, G, bx, lane);
      nun = __builtin_amdgcn_readfirstlane(__shfl(nun, 0)); if (wave == 0) ut[16 * 8] = nun;
      __syncthreads();
      nun = ut[16 * 8]; pg8::TableOrder S{ut, __builtin_amdgcn_readfirstlane(nun)}; pg8::Gemm g{(const bf16*)(ws + WS_HBUF), (const bf16*)(ws + WS_WD_T), HB_ROWS, NE * 1024, 256}; pg8::EpiMoe2 E{ws};
      pg8::gemm_phase<pg8::EpiMoe2, pg8::TableOrder, true, true>(ring, g, S, E, tid); }
    }
    GRID_BAR(); }
    REP(14) {
    { IDS();
    for (int r = gw; r < NTOK; r += NGW) { const int b = r / SEQ;
        const f32x4* xr = (const f32x4*)((const float*)(ws + WS_XL1) + (size_t)r * D) + lane; f32x4 v[4]; float s = 0.f;
#pragma unroll
        for (int j = 0; j < 4; ++j) { f32x4 acc = (f32x4){0.f, 0.f, 0.f, 0.f};
            for (int k = 0; k < 8; ++k) { const u32x2 y = ((const u32x2*)((const bf16*)(ws + WS_YSLOT) + (size_t)(r * 8 + k) * D))[lane + 64 * j];
                acc.x += bf2f(y.x); acc.y += bf2f(y.x >> 16); acc.z += bf2f(y.y); acc.w += bf2f(y.y >> 16); }
            { const u32x2 y = ((const u32x2*)((const bf16*)(ws + WS_YS9) + (size_t)r * D))[lane + 64 * j];
              acc.x += bf2f(y.x); acc.y += bf2f(y.x >> 16); acc.z += bf2f(y.y); acc.w += bf2f(y.y >> 16); }
            const f32x4 g2 = ((const f32x4*)(mod + b * 6144 + 5120))[lane + 64 * j];
            v[j] = xr[64 * j] + g2 * acc; s += (v[j].x * v[j].x + v[j].y * v[j].y) + (v[j].z * v[j].z + v[j].w * v[j].w); }
        const float rr = rsqrtf(wave_sum(s) * (1.f / D) + EPS);
        f32x4* o = (f32x4*)(P.out + (size_t)r * D) + lane;
#pragma unroll
        for (int j = 0; j < 4; ++j) { const f32x4 fg = ((const f32x4*)P.in[30])[lane + 64 * j]; o[64 * j] = v[j] * rr * fg; }
    }
    }
    }
#undef GRID_BAR
}

extern "C" void kernel_launch(void* const* d_in, const int* in_sizes, int n_in, void* d_out, int out_size, void* d_ws, size_t ws_size, hipStream_t stream) {
    static int grid = 0;
    if (grid == 0) {
        if (n_in != 31 || out_size != NTOK * D || ws_size < WS_END) { fprintf(stderr, "kernel_launch: unexpected problem (n_in %d, out %d, ws %zu)\n", n_in, out_size, ws_size); grid = -1; return; }
        int dev = 0, cus = 0, per_cu = 0;
        if (hipGetDevice(&dev) != hipSuccess || hipDeviceGetAttribute(&cus, hipDeviceAttributeMultiprocessorCount, dev) != hipSuccess) { grid = -1; return; }
        if (hipFuncSetAttribute((const void*)mega, hipFuncAttributeMaxDynamicSharedMemorySize, LDS_BYTES) != hipSuccess) { fprintf(stderr, "kernel_launch: hipFuncSetAttribute failed\n"); grid = -1; return; }
        if (hipOccupancyMaxActiveBlocksPerMultiprocessor(&per_cu, (const void*)mega, NTHREADS, LDS_BYTES) != hipSuccess || per_cu < 1) { fprintf(stderr, "kernel_launch: occupancy query says %d blocks per CU\n", per_cu); (void)hipGetLastError(); grid = -1; return; }
        grid = cus;
    }
    if (grid < 0) return;
    Ptrs P{};
    for (int i = 0; i < 31; ++i) P.in[i] = (const float*)d_in[i];
    P.out = (float*)d_out; P.ws = (unsigned char*)d_ws;
    (void)hipMemsetAsync((char*)d_ws + WS_CTL, 0, MiB, stream);
    hipLaunchKernelGGL(mega, dim3(grid), dim3(NTHREADS), LDS_BYTES, stream, P);
}
```
